# Optimizing an MI355X kernel written in HIP

```python
import jax, jax.numpy as jnp
from jax import lax
import numpy as np

D_MODEL = 1024
BATCH = 4
SEQ = 8192
DEPTH = 1

RET_HEADS = 4
RET_DK = 128
RET_DV = 256
RET_CHUNK = 128
SWA_HEADS = 8
SWA_KV_HEADS = 2
SWA_DH = 64
WINDOW = 128
D_FF = 4 * D_MODEL
EPS = 1e-6

RET_QK = RET_HEADS * RET_DK
RET_V = RET_HEADS * RET_DV
SWA_Q = SWA_HEADS * SWA_DH
SWA_KV = SWA_KV_HEADS * SWA_DH
IN_SPLITS = (RET_QK, RET_QK, RET_V, RET_V, SWA_Q, SWA_KV, SWA_KV, D_MODEL, D_MODEL)
D_IN = sum(IN_SPLITS)
SPLIT_IDX = tuple(int(i) for i in np.cumsum(IN_SPLITS)[:-1])

kernel_name = "hybrid_retention_swa_sinks_block"


def rmsnorm(x, g):
    xf = x.astype(jnp.float32)
    y = xf * lax.rsqrt(jnp.mean(xf * xf, axis=-1, keepdims=True) + EPS)
    return (y * g.astype(jnp.float32)).astype(x.dtype)


def retention_chunkwise(q, k, v):
    B, T, H, dk = q.shape
    dv = v.shape[-1]
    C = RET_CHUNK
    N = T // C
    f32 = jnp.float32
    log_gamma = jnp.log(1.0 - jnp.exp2(-5.0 - jnp.arange(H, dtype=f32)))
    q = q.astype(f32).reshape(B, N, C, H, dk)
    k = k.astype(f32).reshape(B, N, C, H, dk) * (dk ** -0.5)
    v = v.astype(f32).reshape(B, N, C, H, dv)
    pos = jnp.arange(C, dtype=f32)
    diff = pos[:, None] - pos[None, :]
    causal = diff >= 0
    decay = jnp.where(causal[None], jnp.exp(log_gamma[:, None, None] * jnp.where(causal, diff, 0.0)[None]), 0.0)
    qk = jnp.einsum('bnihd,bnjhd->bnhij', q, k) * decay[None, None]
    o_inner = jnp.einsum('bnhij,bnjhe->bnihe', qk, v)
    k_dec = k * jnp.exp(log_gamma[None, :] * (C - 1.0 - pos)[:, None])[None, None, :, :, None]
    kv = jnp.einsum('bnjhd,bnjhe->nbhde', k_dec, v)
    chunk_decay = jnp.exp(log_gamma * C)[None, :, None, None]

    def step(s, kv_n):
        return chunk_decay * s + kv_n, s

    _, s_prev = lax.scan(step, jnp.zeros((B, H, dk, dv), f32), kv)
    q_dec = q * jnp.exp(log_gamma[None, :] * (pos + 1.0)[:, None])[None, None, :, :, None]
    o_cross = jnp.einsum('bnihd,nbhde->bnihe', q_dec, s_prev)
    o = (o_inner + o_cross).reshape(B, T, H, dv)
    mu = jnp.mean(o, axis=-1, keepdims=True)
    var = jnp.mean(jnp.square(o - mu), axis=-1, keepdims=True)
    return (o - mu) * lax.rsqrt(var + EPS)


def swa_gqa_sinks(q, k, v, sinks):
    B, T, Hq, dh = q.shape
    G = k.shape[2]
    R = Hq // G
    W = WINDOW
    N = T // W
    f32 = jnp.float32
    qb = q.reshape(B, N, W, G, R, dh)
    kb = k.reshape(B, N, W, G, dh)
    vb = v.reshape(B, N, W, G, dh)
    pad = ((0, 0), (1, 0), (0, 0), (0, 0), (0, 0))
    kk = jnp.concatenate([jnp.pad(kb, pad)[:, :-1], kb], axis=2)
    vv = jnp.concatenate([jnp.pad(vb, pad)[:, :-1], vb], axis=2)
    s = jnp.einsum('bnigrd,bnjgd->bgrnij', qb, kk).astype(f32) * (dh ** -0.5)
    qpos = jnp.arange(W)[:, None] + W
    kpos = jnp.arange(2 * W)[None, :]
    dist = qpos - kpos
    valid = (dist >= 0) & (dist < W)
    blk_valid = valid[None] & ((jnp.arange(N)[:, None, None] > 0) | (kpos >= W)[None])
    slopes = jnp.exp2(-8.0 / Hq * jnp.arange(1, Hq + 1, dtype=f32)).reshape(G, R)
    s = s - slopes[None, :, :, None, None, None] * dist.astype(f32)[None, None, None, None]
    s = jnp.where(blk_valid[None, None, None], s, -jnp.inf)
    sink = sinks.astype(f32).reshape(G, R)[None, :, :, None, None, None]
    m = jnp.maximum(jnp.max(s, axis=-1, keepdims=True), sink)
    p = jnp.exp(s - m)
    p = p / (jnp.sum(p, axis=-1, keepdims=True) + jnp.exp(sink - m))
    out = jnp.einsum('bgrnij,bnjgd->bnigrd', p, vv.astype(f32))
    return out.reshape(B, T, Hq * dh)


def setup_inputs(seed: int = 0) -> dict:
    key = jax.random.key(seed)
    ks = jax.random.split(key, 13)
    f32 = jnp.float32

    def dense(k, fan_in, fan_out):
        return jax.random.normal(k, (DEPTH, fan_in, fan_out), f32) * (fan_in ** -0.5)

    def gain(k):
        return 1.0 + 0.02 * jax.random.normal(k, (DEPTH, D_MODEL), f32)

    return {
        "x": jax.random.normal(ks[0], (BATCH, SEQ, D_MODEL), f32),
        "pre_mix_norm": gain(ks[1]),
        "w_in": dense(ks[2], D_MODEL, D_IN),
        "w_ret_out": dense(ks[3], RET_V, D_MODEL),
        "w_swa_out": dense(ks[4], SWA_Q, D_MODEL),
        "w_out": dense(ks[5], D_MODEL, D_MODEL),
        "sinks": 0.5 * jax.random.normal(ks[6], (DEPTH, SWA_HEADS), f32),
        "post_mix_norm": gain(ks[7]),
        "pre_mlp_norm": gain(ks[8]),
        "w_up": dense(ks[9], D_MODEL, D_FF),
        "w_down": dense(ks[10], D_FF, D_MODEL),
        "post_mlp_norm": gain(ks[11]),
    }


def reference(x, pre_mix_norm, w_in, w_ret_out, w_swa_out, w_out, sinks, post_mix_norm, pre_mlp_norm, w_up, w_down, post_mlp_norm):
    B, T, _ = x.shape
    dt = x.dtype
    for l in range(DEPTH):
        h = rmsnorm(x, pre_mix_norm[l])
        proj = h @ w_in[l]
        q_r, k_r, v_r, g_r, q_s, k_s, v_s, gate_r, gate_s = jnp.split(proj, SPLIT_IDX, axis=-1)
        ret = retention_chunkwise(q_r.reshape(B, T, RET_HEADS, RET_DK),
                                  k_r.reshape(B, T, RET_HEADS, RET_DK),
                                  v_r.reshape(B, T, RET_HEADS, RET_DV)).reshape(B, T, RET_V)
        ret = (jax.nn.silu(g_r.astype(jnp.float32)) * ret).astype(dt)
        y_r = ret @ w_ret_out[l]
        swa = swa_gqa_sinks(q_s.reshape(B, T, SWA_HEADS, SWA_DH),
                            k_s.reshape(B, T, SWA_KV_HEADS, SWA_DH),
                            v_s.reshape(B, T, SWA_KV_HEADS, SWA_DH),
                            sinks[l]).astype(dt)
        y_s = swa @ w_swa_out[l]
        merged = jax.nn.sigmoid(gate_r) * y_r + jax.nn.sigmoid(gate_s) * y_s
        x = x + rmsnorm(merged @ w_out[l], post_mix_norm[l])
        h = rmsnorm(x, pre_mlp_norm[l])
        u = jnp.square(jax.nn.relu(h @ w_up[l]))
        x = x + rmsnorm(u @ w_down[l], post_mlp_norm[l])
    return x
```

```cpp
#include <hip/hip_runtime.h>
#include <hip/hip_cooperative_groups.h>
#include <cstdio>
#include <cstdint>
namespace cg = cooperative_groups;

constexpr int M = 32768, D = 1024, DIN = 5888, FF = 4096, SEQ = 8192;
constexpr float EPS = 1e-6f;
constexpr size_t MiB = 1u << 20;
constexpr size_t OFF_WIN = 1 * MiB, OFF_WR = 13 * MiB, OFF_WS = 15 * MiB, OFF_WO = 16 * MiB, OFF_WUP = 18 * MiB, OFF_WDN = 26 * MiB;
constexpr size_t OFF_QR = 40 * MiB, OFF_KR = 72 * MiB, OFF_VR = 104 * MiB, OFF_GR = 168 * MiB, OFF_QS = 232 * MiB, OFF_KVS = 264 * MiB,
                 OFF_GTR = 280 * MiB, OFF_GTS = 344 * MiB, OFF_ST = 408 * MiB;
constexpr size_t OFF_T = 40 * MiB, OFF_MG = 104 * MiB, OFF_Z = 168 * MiB, OFF_H2 = 40 * MiB, OFF_U = 104 * MiB, OFF_DD = 360 * MiB, WS_NEED = 488 * MiB;
constexpr size_t OUT_SWA = 64 * MiB;
namespace pg8 {
#define PG8_LAS __attribute__((address_space(3)))
typedef unsigned short bf16_t;
typedef short bf16x8 __attribute__((ext_vector_type(8)));
typedef float f32x4 __attribute__((ext_vector_type(4)));
typedef unsigned u32x4 __attribute__((ext_vector_type(4)));
constexpr int BM = 256, BK = 64, HALF = 128, HTB = HALF * BK * 2  , STAGE_BYTES = 8 * HTB, NXCD = 8, WGM = 8;

__host__ __device__ __forceinline__ int lds_byte(int r, int c) { const int st = (r >> 4) * 2 + (c >> 5), rr = r & 15, cc = c & 31, ob = rr * 64 + cc * 2; return st * 1024 + (ob ^ (((ob >> 9) & 1) << 5)); }
__host__ __device__ __forceinline__ void stage_rc(int b, int& R, int& C) { const int st = b / 1024, sb = b % 1024, swz = sb ^ (((sb >> 9) & 1) << 5); R = (st >> 1) * 16 + swz / 64; C = (st & 1) * 32 + (swz % 64) / 2; }
__host__ __device__ __forceinline__ int perm32(int rho) { const int n = rho >> 4, i = rho & 15; return 8 * (i >> 2) + 4 * n + (i & 3); }

struct Unit { int pm, pn; };
struct Gemm { const bf16_t* A; const bf16_t* Bt; int M, N, K; };

struct StaticOrder {
    int nM, nN, nwg, G, c;
    __host__ __device__ void init(int M, int N, int G_, int c_) { nM = M / BM; nN = N / BM; nwg = nM * nN; G = G_; c = c_; }
    __host__ __device__ bool next(int i, Unit& u) const {
        const long L = (long)i * G + c; if (L >= nwg) return false;
        int wgid = (int)L; { const int q = nwg / NXCD, r = nwg % NXCD, xcd = wgid % NXCD, off = wgid / NXCD; wgid = (xcd < r ? xcd * (q + 1) : r * (q + 1) + (xcd - r) * q) + off; }
        const int nig = WGM * nN, gid = wgid / nig, fm = gid * WGM, gsz = (nM - fm) < WGM ? (nM - fm) : WGM;
        u.pm = fm + ((wgid % nig) % gsz); u.pn = (wgid % nig) / gsz; return true;
    }
    __device__ __forceinline__ void a_ready(const Unit&) const {}
    __device__ __forceinline__ void done(const Unit&) const {}
};

__device__ __forceinline__ unsigned cvt_pk_bf16(float lo, float hi) { unsigned r; asm volatile("v_cvt_pk_bf16_f32 %0, %1, %2" : "=v"(r) : "v"(lo), "v"(hi)); return r; }
typedef float f32x2 __attribute__((ext_vector_type(2)));
__device__ __forceinline__ void st8(bf16_t* p, f32x4 v0, f32x4 v1) {
    u32x4 w; w.x = cvt_pk_bf16(v0[0], v0[1]); w.y = cvt_pk_bf16(v0[2], v0[3]); w.z = cvt_pk_bf16(v1[0], v1[1]); w.w = cvt_pk_bf16(v1[2], v1[3]);
    *(u32x4*)p = w;
}
__device__ __forceinline__ void ld8(const bf16_t* p, f32x4& v0, f32x4& v1) {
    const u32x4 w = *(const u32x4*)p;
    v0[0] = __uint_as_float(w.x << 16); v0[1] = __uint_as_float(w.x & 0xffff0000u); v0[2] = __uint_as_float(w.y << 16); v0[3] = __uint_as_float(w.y & 0xffff0000u);
    v1[0] = __uint_as_float(w.z << 16); v1[1] = __uint_as_float(w.z & 0xffff0000u); v1[2] = __uint_as_float(w.w << 16); v1[3] = __uint_as_float(w.w & 0xffff0000u);
}
__device__ __forceinline__ float sigm(float x) { return __builtin_amdgcn_rcpf(1.f + __builtin_amdgcn_exp2f(x * -1.4426950408889634f)); }
template <int MODE> struct EpiB {
    static constexpr bool PERM = true, AFTER_DRAIN = false; static constexpr int MID_T = -1;
    unsigned char* ws; bf16_t* O; int ldc; const bf16_t* G; const bf16_t* T;
    __device__ __forceinline__ void operator()(const f32x4 (&acc)[2][2][4][2], const Unit& u, int wr, int wc, int fr, int fq) const {
        const int row0 = u.pm * BM + wr * 64 + fr; int colt = u.pn * BM; bf16_t* base = O; int ld = ldc; int tm = 0; float sc = 1.f;
        if (MODE == 0) {
            const int pn = u.pn; size_t off; int first;
            if (pn < 2)       { off = OFF_QR;  ld = 512;  first = 0;  tm = 0; }
            else if (pn < 4)  { off = OFF_KR;  ld = 512;  first = 2;  tm = 1; sc = 0.08838834764831845f; }
            else if (pn < 8)  { off = OFF_VR;  ld = 1024; first = 4;  tm = 0; }
            else if (pn < 12) { off = OFF_GR;  ld = 1024; first = 8;  tm = 2; }
            else if (pn < 14) { off = OFF_QS;  ld = 512;  first = 12; tm = 1; sc = 0.125f; }
            else if (pn < 15) { off = OFF_KVS; ld = 256;  first = 14; tm = 0; }
            else if (pn < 19) { off = OFF_GTR; ld = 1024; first = 15; tm = 3; }
            else              { off = OFF_GTS; ld = 1024; first = 19; tm = 3; }
            base = (bf16_t*)(ws + off); colt = (pn - first) * BM;
        }
        const int col0 = colt + wc * 32 + 8 * fq;
#pragma unroll
        for (int ai = 0; ai < 2; ++ai)
#pragma unroll
            for (int m = 0; m < 4; ++m) { const size_t ro = (size_t)(row0 + ai * HALF + m * 16) * ld + col0;
#pragma unroll
                for (int bj = 0; bj < 2; ++bj) { f32x4 v0 = acc[ai][bj][m][0], v1 = acc[ai][bj][m][1];
                    if (MODE == 0) {
                        if (tm == 0) { float one = 1.0f; asm volatile("" : "+v"(one)); v0 = v0 * one; v1 = v1 * one; }
                        else if (tm == 1) { v0 = v0 * sc; v1 = v1 * sc; }
                        else if (tm == 2) {
#pragma unroll
                            for (int q = 0; q < 4; ++q) { v0[q] = v0[q] * sigm(v0[q]); v1[q] = v1[q] * sigm(v1[q]); } }
                        else if (tm == 3) {
#pragma unroll
                            for (int q = 0; q < 4; ++q) { v0[q] = sigm(v0[q]); v1[q] = sigm(v1[q]); } }
                    } else if (MODE == 1) { f32x4 g0, g1; ld8(G + ro + bj * HALF, g0, g1); v0 = v0 * g0; v1 = v1 * g1; }
                    else if (MODE == 2) { f32x4 g0, g1, t0, t1; ld8(G + ro + bj * HALF, g0, g1); ld8(T + ro + bj * HALF, t0, t1); v0 = v0 * g0 + t0; v1 = v1 * g1 + t1; }
                    else if (MODE == 3) {
#pragma unroll
                        for (int q = 0; q < 4; ++q) { const float a = fmaxf(v0[q], 0.f), b = fmaxf(v1[q], 0.f); v0[q] = a * a; v1[q] = b * b; } }
                    st8(base + ro + bj * HALF, v0, v1); } }
    }
};
struct EpiF32 {
    static constexpr bool PERM = false, AFTER_DRAIN = false; static constexpr int MID_T = -1;
    float* O; int ldc;
    __device__ __forceinline__ void operator()(const f32x4 (&acc)[2][2][4][2], const Unit& u, int wr, int wc, int fr, int fq) const {
        const int row0 = u.pm * BM + wr * 64 + fr, col0 = u.pn * BM + wc * 32 + 4 * fq;
#pragma unroll
        for (int ai = 0; ai < 2; ++ai)
#pragma unroll
            for (int m = 0; m < 4; ++m) { float* rp = O + (size_t)(row0 + ai * HALF + m * 16) * ldc + col0;
#pragma unroll
                for (int bj = 0; bj < 2; ++bj)
#pragma unroll
                    for (int n = 0; n < 2; ++n) *(f32x4*)(rp + bj * HALF + n * 16) = acc[ai][bj][m][n]; }
    }
};

struct EpiMerged {
    static constexpr bool PERM = true, AFTER_DRAIN = false; static constexpr int MID_T = 16;
    bf16_t* O; const bf16_t* GR_; const bf16_t* GS_;
    __device__ __forceinline__ void mid(f32x4 (&acc)[2][2][4][2], const Unit& u, int wr, int wc, int fr_, int fq_) const {
        int fr = fr_, fq = fq_; asm volatile("" : "+v"(fr), "+v"(fq));
        const int row0 = u.pm * BM + wr * 64 + fr, col0 = u.pn * BM + wc * 32 + 8 * fq;
#pragma unroll
        for (int ai = 0; ai < 2; ++ai)
#pragma unroll
            for (int m = 0; m < 4; ++m) { const size_t ro = (size_t)(row0 + ai * HALF + m * 16) * 1024 + col0;
#pragma unroll
                for (int bj = 0; bj < 2; ++bj) { f32x4 r0, r1, s0, s1; ld8(GR_ + ro + bj * HALF, r0, r1); ld8(GS_ + ro + bj * HALF, s0, s1);
#pragma unroll
                    for (int q = 0; q < 4; ++q) { acc[ai][bj][m][0][q] *= r0[q] * __builtin_amdgcn_rcpf(fmaxf(s0[q], 1e-30f)); acc[ai][bj][m][1][q] *= r1[q] * __builtin_amdgcn_rcpf(fmaxf(s1[q], 1e-30f)); } }
                __builtin_amdgcn_sched_barrier(0); }
    }
    __device__ __forceinline__ void operator()(const f32x4 (&acc)[2][2][4][2], const Unit& u, int wr, int wc, int fr, int fq) const {
        const int row0 = u.pm * BM + wr * 64 + fr, col0 = u.pn * BM + wc * 32 + 8 * fq;
#pragma unroll
        for (int ai = 0; ai < 2; ++ai)
#pragma unroll
            for (int m = 0; m < 4; ++m) { const size_t ro = (size_t)(row0 + ai * HALF + m * 16) * 1024 + col0;
#pragma unroll
                for (int bj = 0; bj < 2; ++bj) { f32x4 s0, s1; ld8(GS_ + ro + bj * HALF, s0, s1); st8(O + ro + bj * HALF, acc[ai][bj][m][0] * s0, acc[ai][bj][m][1] * s1); } }
    }
};
struct OneUnit {
    StaticOrder base; int pass;
    __device__ bool next(int i, Unit& u) const { if (i != 0) return false; return base.next(pass, u); }
    __device__ __forceinline__ void a_ready(const Unit&) const {}
    __device__ __forceinline__ void done(const Unit&) const {}
};
struct RowSq {
    float* slots;
    unsigned* cnt;
    float eps;
    __device__ __forceinline__ void run(const f32x4 (&v)[2][2][4][2], const Unit& u, int wr, int wc, int fr, int fq, PG8_LAS unsigned char* lds, int wid, int lane) const {
        PG8_LAS float* P = (PG8_LAS float*)lds;
        PG8_LAS float* S = (PG8_LAS float*)(lds + 8192);
#pragma unroll
        for (int ai = 0; ai < 2; ++ai)
#pragma unroll
            for (int m = 0; m < 4; ++m) {
                float s = 0.f;
#pragma unroll
                for (int bj = 0; bj < 2; ++bj)
#pragma unroll
                    for (int n = 0; n < 2; ++n) { const f32x4 x = v[ai][bj][m][n]; s += (x[0] * x[0] + x[1] * x[1]) + (x[2] * x[2] + x[3] * x[3]); }
                s += __shfl_xor(s, 16); s += __shfl_xor(s, 32);
                if (fq == 0) P[(ai * HALF + wr * 64 + m * 16 + fr) * 4 + wc] = s;
            }
        asm volatile("s_waitcnt lgkmcnt(0)" ::: "memory"); __builtin_amdgcn_s_barrier(); asm volatile("" ::: "memory");
        const int row = wid * 32 + (lane & 31);
        if (lane < 32) {
            const float tot = (P[row * 4 + 0] + P[row * 4 + 1]) + (P[row * 4 + 2] + P[row * 4 + 3]);
            __hip_atomic_store(slots + (size_t)(u.pm * BM + row) * 4 + u.pn, tot, __ATOMIC_RELAXED, __HIP_MEMORY_SCOPE_AGENT);
        }
        asm volatile("s_waitcnt vmcnt(0)" ::: "memory");
        if (lane == 0) __hip_atomic_fetch_add(cnt + 64 * u.pm, 1u, __ATOMIC_RELAXED, __HIP_MEMORY_SCOPE_AGENT);
        if (wid == 0) {
            unsigned spins = 0;
            while ((unsigned)__builtin_amdgcn_readfirstlane(__hip_atomic_load(cnt + 64 * u.pm, __ATOMIC_RELAXED, __HIP_MEMORY_SCOPE_AGENT)) < 32u) {
                __builtin_amdgcn_s_sleep(2); if (++spins > (1u << 24)) break; }
            __builtin_amdgcn_fence(__ATOMIC_ACQUIRE, "agent");
        }
        asm volatile("s_waitcnt vmcnt(0) lgkmcnt(0)" ::: "memory"); __builtin_amdgcn_s_barrier(); asm volatile("" ::: "memory");
        if (lane < 32) {
            const float* sl = slots + (size_t)(u.pm * BM + row) * 4; float t = 0.f;
#pragma unroll
            for (int k = 0; k < 4; ++k) t += __hip_atomic_load(sl + k, __ATOMIC_RELAXED, __HIP_MEMORY_SCOPE_AGENT);
            S[row] = rsqrtf(t * (1.0f / 1024.0f) + eps);
        }
        asm volatile("s_waitcnt lgkmcnt(0)" ::: "memory"); __builtin_amdgcn_s_barrier(); asm volatile("" ::: "memory");
    }
};
struct EpiRmsResRms {
    static constexpr bool PERM = true, AFTER_DRAIN = true; static constexpr int MID_T = -1;
    const float* base; bf16_t* out; bf16_t* xn; const float* g1; const float* g2; RowSq st1, st2;
    __device__ __forceinline__ void fused(f32x4 (&acc)[2][2][4][2], const Unit& u, int wr, int wc, int fr, int fq, PG8_LAS unsigned char* lds, int wid, int lane) const {
        typedef unsigned u32x2v __attribute__((ext_vector_type(2)));
        const PG8_LAS float* S = (const PG8_LAS float*)(lds + 8192);
        const int col0 = u.pn * BM + wc * 32 + 8 * fq;
        st1.run(acc, u, wr, wc, fr, fq, lds, wid, lane);
#pragma unroll
        for (int ai = 0; ai < 2; ++ai)
#pragma unroll
            for (int m = 0; m < 4; ++m) { const int r = ai * HALF + wr * 64 + m * 16 + fr; const float sr = S[r]; const size_t off = (size_t)(u.pm * BM + r) * 1024 + col0;
#pragma unroll
                for (int bj = 0; bj < 2; ++bj)
#pragma unroll
                    for (int n = 0; n < 2; ++n) { const f32x4 bs = *(const f32x4*)(base + off + bj * HALF + n * 4); const f32x4 gv = *(const f32x4*)(g1 + col0 + bj * HALF + n * 4);
                        acc[ai][bj][m][n] = bs + acc[ai][bj][m][n] * sr * gv; }
                asm volatile("" : "+v"(acc[ai][0][m][0]), "+v"(acc[ai][0][m][1]), "+v"(acc[ai][1][m][0]), "+v"(acc[ai][1][m][1]));
                if (m & 1) asm volatile("" ::: "memory"); }
        st2.run(acc, u, wr, wc, fr, fq, lds, wid, lane);
#pragma unroll
        for (int ai = 0; ai < 2; ++ai)
#pragma unroll
            for (int m = 0; m < 4; ++m) { const int r = ai * HALF + wr * 64 + m * 16 + fr; const float sr = S[r]; const size_t off = (size_t)(u.pm * BM + r) * 1024 + col0;
#pragma unroll
                for (int bj = 0; bj < 2; ++bj) { const f32x4 xa = acc[ai][bj][m][0], xb = acc[ai][bj][m][1];
                    u32x4 w1; w1.x = cvt_pk_bf16(xa[0], xa[1]); w1.y = cvt_pk_bf16(xa[2], xa[3]); w1.z = cvt_pk_bf16(xb[0], xb[1]); w1.w = cvt_pk_bf16(xb[2], xb[3]); *(u32x4*)(out + off + bj * HALF) = w1;
                    const f32x4 ga = *(const f32x4*)(g2 + col0 + bj * HALF), gb = *(const f32x4*)(g2 + col0 + bj * HALF + 4); const f32x4 oa = xa * sr * ga, ob = xb * sr * gb;
                    u32x4 w; w.x = cvt_pk_bf16(oa[0], oa[1]); w.y = cvt_pk_bf16(oa[2], oa[3]); w.z = cvt_pk_bf16(ob[0], ob[1]); w.w = cvt_pk_bf16(ob[2], ob[3]); *(u32x4*)(xn + off + bj * HALF) = w; }
                asm volatile("" ::: "memory"); }
    }
};
struct EpiRmsRes {
    static constexpr bool PERM = true, AFTER_DRAIN = true; static constexpr int MID_T = -1;
    const bf16_t* base; float* out; const float* g1; RowSq st;
    __device__ __forceinline__ void fused(f32x4 (&acc)[2][2][4][2], const Unit& u, int wr, int wc, int fr, int fq, PG8_LAS unsigned char* lds, int wid, int lane) const {
        const PG8_LAS float* S = (const PG8_LAS float*)(lds + 8192);
        const int col0 = u.pn * BM + wc * 32 + 8 * fq;
        st.run(acc, u, wr, wc, fr, fq, lds, wid, lane);
#pragma unroll
        for (int ai = 0; ai < 2; ++ai)
#pragma unroll
            for (int m = 0; m < 4; ++m) { const int r = ai * HALF + wr * 64 + m * 16 + fr; const float sr = S[r]; const size_t off = (size_t)(u.pm * BM + r) * 1024 + col0;
#pragma unroll
                for (int bj = 0; bj < 2; ++bj) { f32x4 ba, bb; ld8(base + off + bj * HALF, ba, bb);
                    const f32x4 ga = *(const f32x4*)(g1 + col0 + bj * HALF), gb = *(const f32x4*)(g1 + col0 + bj * HALF + 4);
                    *(f32x4*)(out + off + bj * HALF) = ba + acc[ai][bj][m][0] * sr * ga; *(f32x4*)(out + off + bj * HALF + 4) = bb + acc[ai][bj][m][1] * sr * gb; }
                if (m & 1) asm volatile("" ::: "memory"); }
    }
};
template <class Epi, class Sched, bool ALIGN_EPI = false, bool SP2 = false>
__device__ __forceinline__ void gemm_phase(PG8_LAS unsigned char* lds, const Gemm g, const Sched& S, const Epi& E) {
    const int tid = threadIdx.x, wid = __builtin_amdgcn_readfirstlane(tid >> 6), lane = tid & 63, wr = wid >> 2, wc = wid & 3, fr = lane & 15, fq = lane >> 4;
    const int K = g.K, nt = K / BK;
    unsigned voffA[2], voffB[2];
#pragma unroll
    for (int i = 0; i < 2; ++i) { int R, C; stage_rc(tid * 16 + i * 8192, R, C); const int Rb = Epi::PERM ? ((R & ~31) + perm32(R & 31)) : R;
        voffA[i] = (unsigned)(R * K + C) * 2u; voffB[i] = (unsigned)(Rb * K + C) * 2u; }
    const size_t kstep = (size_t)(BK * 2);
    const size_t hstep = (size_t)HALF * K * 2;
    const size_t tstep = 2 * hstep;
    const unsigned ldsw = (unsigned)wid * 1024u;
    const int aoff = lds_byte(wr * 64 + fr, fq * 8), boff = lds_byte(wc * 32 + fr, fq * 8);
#define PG8_SA(b, h) (((b) * 2 + (h)) * HTB)
#define PG8_SB(b, h) ((4 + (b) * 2 + (h)) * HTB)
#define PG8_STAGE(bufoff, gbase, voff) do { _Pragma("unroll") for (int _i = 0; _i < 2; ++_i) \
        __builtin_amdgcn_global_load_lds((const unsigned*)((const char*)(gbase) + (voff)[_i]), (PG8_LAS unsigned*)(lds + (bufoff) + ldsw + _i * 8192), 16, 0, 0); } while (0)
#define PG8_LDA(dst, b, h) do { _Pragma("unroll") for (int m = 0; m < 4; ++m) _Pragma("unroll") for (int k = 0; k < 2; ++k) dst[m][k] = *(const PG8_LAS bf16x8*)(lds + PG8_SA(b, h) + aoff + m * 2048 + k * 1024); } while (0)
#define PG8_LDB(dst, b, h) do { _Pragma("unroll") for (int n = 0; n < 2; ++n) _Pragma("unroll") for (int k = 0; k < 2; ++k) dst[n][k] = *(const PG8_LAS bf16x8*)(lds + PG8_SB(b, h) + boff + n * 2048 + k * 1024); } while (0)
#define PG8_MMA(ai, bj, At, Bt) do { __builtin_amdgcn_s_setprio(1); _Pragma("unroll") for (int m = 0; m < 4; ++m) _Pragma("unroll") for (int n = 0; n < 2; ++n) _Pragma("unroll") for (int k = 0; k < 2; ++k) \
        acc[ai][bj][m][n] = __builtin_amdgcn_mfma_f32_16x16x32_bf16(Bt[n][k], At[m][k], acc[ai][bj][m][n], 0, 0, 0); __builtin_amdgcn_s_setprio(0); } while (0)
#define PG8_WAIT_V(n) asm volatile("s_waitcnt vmcnt(" #n ")" ::: "memory")
#define PG8_WAIT_L(n) asm volatile("s_waitcnt lgkmcnt(" #n ")" ::: "memory")
#define PG8_BAR __builtin_amdgcn_s_barrier()
#define PG8_SCHED __builtin_amdgcn_sched_barrier(0)
    Unit cur, nxt; int ui = 0;
    if (!S.next(0, cur)) return;
    f32x4 acc[2][2][4][2];
#pragma unroll
    for (int a = 0; a < 2; ++a)
#pragma unroll
        for (int b = 0; b < 2; ++b)
#pragma unroll
            for (int m = 0; m < 4; ++m)
#pragma unroll
                for (int n = 0; n < 2; ++n) acc[a][b][m][n] = (f32x4){0.f, 0.f, 0.f, 0.f};
    bf16x8 At[4][2], B0[2][2], B1[2][2];
    const char* cA = (const char*)g.A + (size_t)cur.pm * tstep; const char* cB = (const char*)g.Bt + (size_t)cur.pn * tstep;
    S.a_ready(cur);
    if constexpr (SP2) {
        PG8_STAGE(PG8_SB(0, 0), cB, voffB); PG8_STAGE(PG8_SB(0, 1), cB + hstep, voffB); PG8_STAGE(PG8_SA(0, 0), cA, voffA); PG8_STAGE(PG8_SA(0, 1), cA + hstep, voffA);
        if (wr == 1) PG8_BAR;
        PG8_WAIT_V(2); PG8_BAR;
        PG8_STAGE(PG8_SB(1, 0), cB + kstep, voffB); PG8_STAGE(PG8_SA(1, 0), cA + kstep, voffA); PG8_STAGE(PG8_SB(1, 1), cB + hstep + kstep, voffB);
        PG8_WAIT_V(6); PG8_BAR;
    } else {
        PG8_STAGE(PG8_SB(0, 0), cB, voffB); PG8_STAGE(PG8_SA(0, 0), cA, voffA); PG8_STAGE(PG8_SB(0, 1), cB + hstep, voffB); PG8_STAGE(PG8_SA(0, 1), cA + hstep, voffA);
        if (wr == 1) PG8_BAR;
        PG8_WAIT_V(4); PG8_BAR;
        PG8_STAGE(PG8_SB(1, 0), cB + kstep, voffB); PG8_STAGE(PG8_SA(1, 0), cA + kstep, voffA); PG8_STAGE(PG8_SB(1, 1), cB + hstep + kstep, voffB);
        PG8_WAIT_V(6); PG8_BAR;
    }
    for (;;) {
        const bool has_next = S.next(ui + 1, nxt);
        const char* nA = has_next ? (const char*)g.A + (size_t)nxt.pm * tstep : cA; const char* nB = has_next ? (const char*)g.Bt + (size_t)nxt.pn * tstep : cB;
        for (int t = 0; t < nt; t += 2) {
            if constexpr (Epi::MID_T >= 0) { if (t == Epi::MID_T) E.mid(acc, cur, wr, wc, fr, fq); }
            const bool last = (t == nt - 2);
            const char* a1 = cA + (size_t)(t + 1) * kstep;
            const char* a2 = last ? nA : cA + (size_t)(t + 2) * kstep; const char* b2 = last ? nB : cB + (size_t)(t + 2) * kstep;
            const char* a3 = a2 + kstep; const char* b3 = b2 + kstep;
            if (last && has_next) S.a_ready(nxt);
            if constexpr (SP2) {
            PG8_LDB(B0, 0, 0); PG8_LDB(B1, 0, 1); PG8_SCHED; PG8_LDA(At, 0, 0); PG8_STAGE(PG8_SA(1, 1), a1 + hstep, voffA);
            PG8_WAIT_V(8); PG8_WAIT_L(0); PG8_BAR; PG8_MMA(0, 0, At, B0); PG8_MMA(0, 1, At, B1); PG8_BAR; PG8_SCHED;
            PG8_LDA(At, 0, 1); PG8_STAGE(PG8_SB(0, 0), b2, voffB); PG8_STAGE(PG8_SB(0, 1), b2 + hstep, voffB); PG8_STAGE(PG8_SA(0, 0), a2, voffA);
            PG8_WAIT_V(8); PG8_WAIT_L(0); PG8_BAR; PG8_MMA(1, 0, At, B0); PG8_MMA(1, 1, At, B1); PG8_BAR; PG8_SCHED;
            PG8_LDB(B0, 1, 0); PG8_LDB(B1, 1, 1); PG8_SCHED; PG8_LDA(At, 1, 0); PG8_STAGE(PG8_SA(0, 1), a2 + hstep, voffA);
            PG8_WAIT_V(8); PG8_WAIT_L(0); PG8_BAR; PG8_MMA(0, 0, At, B0); PG8_MMA(0, 1, At, B1); PG8_BAR; PG8_SCHED;
            PG8_LDA(At, 1, 1); PG8_STAGE(PG8_SB(1, 0), b3, voffB); PG8_STAGE(PG8_SB(1, 1), b3 + hstep, voffB); PG8_STAGE(PG8_SA(1, 0), a3, voffA);
            PG8_WAIT_V(8); PG8_WAIT_L(0); PG8_BAR; PG8_MMA(1, 0, At, B0); PG8_MMA(1, 1, At, B1); PG8_BAR; PG8_SCHED;
            } else {
            PG8_LDB(B0, 0, 0); PG8_SCHED; PG8_LDA(At, 0, 0); PG8_STAGE(PG8_SA(1, 1), a1 + hstep, voffA);
            PG8_WAIT_L(8); PG8_BAR; PG8_WAIT_L(0); PG8_MMA(0, 0, At, B0); PG8_BAR; PG8_SCHED;
            PG8_LDB(B1, 0, 1); PG8_STAGE(PG8_SB(0, 0), b2, voffB);
            PG8_BAR; PG8_WAIT_L(0); PG8_MMA(0, 1, At, B1); PG8_BAR;
            PG8_LDA(At, 0, 1); PG8_STAGE(PG8_SA(0, 0), a2, voffA);
            PG8_BAR; PG8_WAIT_L(0); PG8_MMA(1, 0, At, B0); PG8_BAR; PG8_SCHED;
            PG8_STAGE(PG8_SB(0, 1), b2 + hstep, voffB);
            PG8_WAIT_V(6); PG8_BAR; PG8_MMA(1, 1, At, B1); PG8_BAR;
            PG8_LDB(B0, 1, 0); PG8_SCHED; PG8_LDA(At, 1, 0); PG8_STAGE(PG8_SA(0, 1), a2 + hstep, voffA);
            PG8_WAIT_L(8); PG8_BAR; PG8_WAIT_L(0); PG8_MMA(0, 0, At, B0); PG8_BAR; PG8_SCHED;
            PG8_LDB(B1, 1, 1); PG8_STAGE(PG8_SB(1, 0), b3, voffB);
            PG8_BAR; PG8_WAIT_L(0); PG8_MMA(0, 1, At, B1); PG8_BAR;
            PG8_LDA(At, 1, 1); PG8_STAGE(PG8_SA(1, 0), a3, voffA);
            PG8_BAR; PG8_WAIT_L(0); PG8_MMA(1, 0, At, B0); PG8_BAR; PG8_SCHED;
            PG8_STAGE(PG8_SB(1, 1), b3 + hstep, voffB);
            PG8_WAIT_V(6); PG8_BAR; PG8_MMA(1, 1, At, B1); PG8_BAR;
            }
        }
        if constexpr (ALIGN_EPI) { if (wr == 0) PG8_BAR; }
        if constexpr (!Epi::AFTER_DRAIN) { E(acc, cur, wr, wc, fr, fq); S.done(cur); }
        if (!has_next) break;
#pragma unroll
        for (int a = 0; a < 2; ++a)
#pragma unroll
            for (int b = 0; b < 2; ++b)
#pragma unroll
                for (int m = 0; m < 4; ++m)
#pragma unroll
                    for (int n = 0; n < 2; ++n) acc[a][b][m][n] = (f32x4){0.f, 0.f, 0.f, 0.f};
        cur = nxt; cA = nA; cB = nB; ++ui;
        if constexpr (ALIGN_EPI) { if (wr == 1) PG8_BAR; }
    }
    PG8_WAIT_V(0);
    if constexpr (!ALIGN_EPI) { if (wr == 0) PG8_BAR; }
    PG8_BAR;
    if constexpr (Epi::AFTER_DRAIN) { E.fused(acc, cur, wr, wc, fr, fq, lds, wid, lane); S.done(cur); }
#undef PG8_SA
#undef PG8_SB
#undef PG8_STAGE
#undef PG8_LDA
#undef PG8_LDB
#undef PG8_MMA
#undef PG8_WAIT_V
#undef PG8_WAIT_L
#undef PG8_BAR
#undef PG8_SCHED
}
}
#ifndef USE_NEW_KV
#define USE_NEW_KV 1
#endif
#ifndef USE_NEW_SWA
#define USE_NEW_SWA 1
#endif
#ifndef USE_NEW_RET
#define USE_NEW_RET 1
#endif
#define LAS __attribute__((address_space(3)))
typedef unsigned short bf16;
typedef float f32x4 __attribute__((ext_vector_type(4)));
typedef unsigned v4u __attribute__((ext_vector_type(4)));
typedef unsigned v2u __attribute__((ext_vector_type(2)));
constexpr int NWAVES = 8, NTHR = 512;
constexpr int LDS_BYTES = 147456;
__device__ __forceinline__ unsigned f2bf(float f) { unsigned u = __builtin_bit_cast(unsigned, f); return (u + 0x7fffu + ((u >> 16) & 1u)) >> 16; }
__device__ __forceinline__ unsigned pk2(float lo, float hi) { return f2bf(lo) | (f2bf(hi) << 16); }
__device__ __forceinline__ float bf2f(bf16 b) { return __uint_as_float((unsigned)b << 16); }
__device__ __forceinline__ float wave_sum(float v) {
#pragma unroll
    for (int o = 1; o < 64; o <<= 1) v += __shfl_xor(v, o);
    return v;
}
#define LDS_WAIT() asm volatile("s_waitcnt lgkmcnt(0)" ::: "memory")

#define XB_TMO      128
#define XB_XCNT(j)  (256  + 64 * (j))
#define XB_XSUB(j)  (1280 + 64 * (j))
#define XB_XGEN(j)  (2304 + 64 * (j))
#define XB_TOP      3328
#define XB_TOPGEN   3392
#define XCD_BAR_WORDS 3456
#define XB_SPIN_CAP (1u << 18)

__device__ __forceinline__ unsigned xb_ld(unsigned* p)              { return __hip_atomic_load(p, __ATOMIC_RELAXED, __HIP_MEMORY_SCOPE_AGENT); }
__device__ __forceinline__ unsigned xb_add(unsigned* p, unsigned v) { return __hip_atomic_fetch_add(p, v, __ATOMIC_RELAXED, __HIP_MEMORY_SCOPE_AGENT); }
__device__ __forceinline__ unsigned xb_xcc_id() { return (unsigned)__builtin_amdgcn_s_getreg((3 << 11) | 20) & 0xFu; }
#define XB_SPIN(cond, bar) do { unsigned _sp = 0; while (cond) { __builtin_amdgcn_s_sleep(1); \
    if ((++_sp & 255u) == 0u) { if (xb_ld(&(bar)[XB_TMO])) break; if (_sp > XB_SPIN_CAP) { atomicAdd(&(bar)[XB_TMO], 1u); break; } } } } while (0)

struct XcdBarrier {
    unsigned* bar; unsigned x;
    volatile LAS unsigned* st;
};

__device__ __forceinline__ XcdBarrier xcd_barrier_post(unsigned* bar, volatile LAS unsigned* st) {
    XcdBarrier b; b.bar = bar; b.x = xb_xcc_id(); b.st = st;
    if (threadIdx.x == 0) (void)xb_add(&bar[XB_XCNT(b.x)], 1u);
    return b;
}
__device__ __forceinline__ void xcd_barrier_complete(unsigned* bar, unsigned x, unsigned& nloc, unsigned& nx) {
    const unsigned G = gridDim.x * gridDim.y * gridDim.z;
    unsigned sum, cnt, mine, sp = 0u;
    for (;;) {
        sum = 0u; cnt = 0u; mine = 0u;
#pragma unroll
        for (unsigned j = 0; j < 16; ++j) { const unsigned c = xb_ld(&bar[XB_XCNT(j)]); sum += c; cnt += (c > 0u) ? 1u : 0u; mine = (j == x) ? c : mine; }
        if (sum == G) break;
        __builtin_amdgcn_s_sleep(1);
        if ((++sp & 255u) == 0u) { if (xb_ld(&bar[XB_TMO])) break; if (sp > XB_SPIN_CAP) { atomicAdd(&bar[XB_TMO], 1u); break; } }
    }
    nloc = mine > 0u ? mine : 1u; nx = cnt > 0u ? cnt : 1u;
}

__device__ __forceinline__ void xcd_barrier(const XcdBarrier& b) {
    asm volatile("s_waitcnt vmcnt(0)" ::: "memory");
    __syncthreads();
    if (threadIdx.x == 0) {
        unsigned* bar = b.bar;
        __builtin_amdgcn_s_waitcnt(0);
        unsigned nloc = b.st[0], nx = b.st[1];
        if (nloc == 0u) { xcd_barrier_complete(bar, b.x, nloc, nx); b.st[0] = nloc; b.st[1] = nx; }
        const unsigned old = xb_add(&bar[XB_XSUB(b.x)], 1u);
        const unsigned gen = old / nloc;
        if (old + 1u == (gen + 1u) * nloc) {
            __builtin_amdgcn_fence(__ATOMIC_RELEASE, "agent");
            asm volatile("s_waitcnt vmcnt(0)" ::: "memory");
            const unsigned og = xb_add(&bar[XB_TOP], 1u);
            const unsigned tg = og / nx;
            if (og + 1u == (tg + 1u) * nx) xb_add(&bar[XB_TOPGEN], 1u);
            else XB_SPIN(xb_ld(&bar[XB_TOPGEN]) == tg, bar);
            __builtin_amdgcn_fence(__ATOMIC_ACQUIRE, "agent");
            xb_add(&bar[XB_XGEN(b.x)], 1u);
            asm volatile("s_waitcnt vmcnt(0)" ::: "memory");
        } else {
            XB_SPIN(xb_ld(&bar[XB_XGEN(b.x)]) == gen, bar);
            __builtin_amdgcn_fence(__ATOMIC_ACQUIRE, "agent");
            asm volatile("s_waitcnt vmcnt(0)" ::: "memory");
        }
    }
    __syncthreads();
}

__device__ __forceinline__ void p0_transpose_item(const float* W, int K, int N, bf16* WT, LAS float* scr, int item, int lane, int ldk = 0, int koff = 0) {
    if (ldk == 0) ldk = K;
    const int nblk = N / 32, kb = item / nblk, nb = item % nblk, k0 = 64 * kb, n0 = 32 * nb;
    float wv[32];
#pragma unroll
    for (int i = 0; i < 32; ++i) { const int kk = 2 * i + (lane >> 5); wv[i] = W[(size_t)(k0 + kk) * N + n0 + (lane & 31)]; }
#pragma unroll
    for (int i = 0; i < 32; ++i) { const int kk = 2 * i + (lane >> 5); scr[kk * 33 + (lane & 31)] = wv[i]; }
    LDS_WAIT(); asm volatile("" ::: "memory");
    const int c = lane & 7;
#pragma unroll
    for (int j = 0; j < 4; ++j) { const int n = (lane >> 3) + 8 * j; const LAS float* s = scr + (8 * c) * 33 + n;
        v4u o; o.x = pk2(s[0 * 33], s[1 * 33]); o.y = pk2(s[2 * 33], s[3 * 33]); o.z = pk2(s[4 * 33], s[5 * 33]); o.w = pk2(s[6 * 33], s[7 * 33]);
        *(v4u*)(WT + (size_t)(n0 + n) * ldk + koff + k0 + 8 * c) = o; }
    LDS_WAIT(); asm volatile("" ::: "memory");
}

typedef short bf16x8 __attribute__((ext_vector_type(8)));
typedef short s16x4 __attribute__((ext_vector_type(4)));
typedef short v4i16_t __attribute__((ext_vector_type(4)));
__device__ __forceinline__ s16x4 trrd(const LAS unsigned char* p) { return __builtin_bit_cast(s16x4, __builtin_amdgcn_ds_read_tr16_b64_v4i16((LAS v4i16_t*)p)); }
__device__ __forceinline__ bf16x8 cat8(s16x4 a, s16x4 b) { return __builtin_shufflevector(a, b, 0, 1, 2, 3, 4, 5, 6, 7); }
__device__ __forceinline__ bf16x8 packf8(f32x4 a, f32x4 b) {
    v4u w; w.x = pg8::cvt_pk_bf16(a[0], a[1]); w.y = pg8::cvt_pk_bf16(a[2], a[3]); w.z = pg8::cvt_pk_bf16(b[0], b[1]); w.w = pg8::cvt_pk_bf16(b[2], b[3]);
    return __builtin_bit_cast(bf16x8, w);
}
__device__ __forceinline__ float vis1() { float one = 1.0f; asm volatile("" : "+v"(one)); return one; }
__device__ __forceinline__ v2u packf4(f32x4 a) { v2u w; w.x = pg8::cvt_pk_bf16(a[0], a[1]); w.y = pg8::cvt_pk_bf16(a[2], a[3]); return w; }
__device__ __forceinline__ f32x4 unpk4(v2u w) { f32x4 r; r[0] = __uint_as_float(w.x << 16); r[1] = __uint_as_float(w.x & 0xffff0000u); r[2] = __uint_as_float(w.y << 16); r[3] = __uint_as_float(w.y & 0xffff0000u); return r; }
#define MFMA16(a, b, c) __builtin_amdgcn_mfma_f32_16x16x32_bf16((a), (b), (c), 0, 0, 0)

__device__ __forceinline__ void kv_unit(LAS unsigned char* lds, const bf16* KR, const bf16* VR, bf16* ST, int unit, int tid, int lane, int wid) {
    constexpr int PBK = 288, PBV = 544;
    LAS unsigned char* Kimg = lds; LAS unsigned char* Vimg = lds + 128 * PBK;
    const int n = unit & 63, bh = unit >> 6, b = bh >> 2, h = bh & 3;
    const float lg2 = log2f(1.f - exp2f(-5.f - (float)h));
    const size_t t0 = (size_t)b * SEQ + n * 128;
#pragma unroll
    for (int it = 0; it < 4; ++it) { const int c = tid + it * NTHR, j = c >> 4, ch = c & 15;
        const v4u w = *(const v4u*)(KR + (t0 + j) * 512 + h * 128 + ch * 8); const float dec = exp2f((float)(127 - j) * lg2);
        const f32x4 a = unpk4((v2u){w.x, w.y}) * dec, bb = unpk4((v2u){w.z, w.w}) * dec;
        *(LAS bf16x8*)(Kimg + j * PBK + ch * 16) = packf8(a, bb); }
#pragma unroll
    for (int it = 0; it < 8; ++it) { const int c = tid + it * NTHR, j = c >> 5, ch = c & 31;
        *(LAS v4u*)(Vimg + j * PBV + ch * 16) = *(const v4u*)(VR + (t0 + j) * 1024 + h * 256 + ch * 8); }
    __syncthreads();
    const int c16 = lane & 15, g = lane >> 4, q = c16 >> 2, p = c16 & 3;
    f32x4 acc[8][2];
#pragma unroll
    for (int dt = 0; dt < 8; ++dt) { acc[dt][0] = (f32x4){0.f, 0.f, 0.f, 0.f}; acc[dt][1] = (f32x4){0.f, 0.f, 0.f, 0.f}; }
#pragma unroll
    for (int ks = 0; ks < 4; ++ks) {
        const LAS unsigned char* ka = Kimg + (32 * ks + 4 * g + q) * PBK + p * 8;
        const LAS unsigned char* va = Vimg + (32 * ks + 4 * g + q) * PBV + p * 8 + wid * 64;
        bf16x8 B[2];
#pragma unroll
        for (int et = 0; et < 2; ++et) B[et] = cat8(trrd(va + et * 32), trrd(va + 16 * PBV + et * 32));
#pragma unroll
        for (int dt = 0; dt < 8; ++dt) { const bf16x8 A = cat8(trrd(ka + dt * 32), trrd(ka + 16 * PBK + dt * 32));
            acc[dt][0] = MFMA16(A, B[0], acc[dt][0]); acc[dt][1] = MFMA16(A, B[1], acc[dt][1]); }
    }
#pragma unroll
    for (int dt = 0; dt < 8; ++dt)
#pragma unroll
        for (int et = 0; et < 2; ++et) *(v2u*)(ST + ((size_t)unit * 256 + 32 * wid + 16 * et + c16) * 128 + 16 * dt + 4 * g) = packf4(acc[dt][et] * vis1());
    __syncthreads();
}

__device__ __forceinline__ void swa_unit(LAS unsigned char* lds, const bf16* QS, const bf16* KVS, const float* sinks, bf16* SWA, int unit, int tid, int lane, int wid) {
    constexpr int PK = 144, PV = 160;
    LAS unsigned char* Kimg = lds; LAS unsigned char* Vimg = lds + 256 * PK;
    const int g2 = unit & 1, n = (unit >> 1) & 63, b = unit >> 7;
    const size_t t0 = (size_t)b * SEQ + n * 128;
#pragma unroll
    for (int it = 0; it < 4; ++it) { const int c = tid + it * NTHR, j = c >> 3, ch = c & 7;
        v4u wk = (v4u){0u, 0u, 0u, 0u}, wv = (v4u){0u, 0u, 0u, 0u};
        if (n > 0 || j >= 128) { const bf16* src = KVS + (t0 + j - 128) * 256 + g2 * 64 + ch * 8; wk = *(const v4u*)src; wv = *(const v4u*)(src + 128); }
        *(LAS v4u*)(Kimg + j * PK + ch * 16) = wk; *(LAS v4u*)(Vimg + j * PV + ch * 16) = wv; }
    __syncthreads();
    const int c16 = lane & 15, g = lane >> 4, q = c16 >> 2, p = c16 & 3;
    const int jt0 = 2 * (wid >> 1), i = 16 * wid + c16;
#pragma unroll 1
    for (int r = 0; r < 4; ++r) {
        const int hq = g2 * 4 + r;
        const float slope = exp2f(-(float)(hq + 1)), sink = sinks[hq];
        bf16x8 qf[2];
#pragma unroll
        for (int ks = 0; ks < 2; ++ks) qf[ks] = *(const bf16x8*)(QS + (t0 + i) * 512 + hq * 64 + 32 * ks + 8 * g);
        f32x4 s[10];
#pragma unroll
        for (int jt = 0; jt < 10; ++jt) { s[jt] = (f32x4){0.f, 0.f, 0.f, 0.f};
#pragma unroll
            for (int ks = 0; ks < 2; ++ks) { const bf16x8 A = *(const LAS bf16x8*)(Kimg + (16 * (jt0 + jt) + c16) * PK + (32 * ks + 8 * g) * 2); s[jt] = MFMA16(A, qf[ks], s[jt]); } }
        float mx = sink;
#pragma unroll
        for (int jt = 0; jt < 10; ++jt)
#pragma unroll
            for (int rr = 0; rr < 4; ++rr) { const int j = 16 * (jt0 + jt) + 4 * g + rr, dist = i + 128 - j;
                const bool valid = dist >= 0 && dist < 128 && (n > 0 || j >= 128);
                const float v = valid ? s[jt][rr] - slope * (float)dist : -INFINITY; s[jt][rr] = v; mx = fmaxf(mx, v); }
        mx = fmaxf(mx, __shfl_xor(mx, 16)); mx = fmaxf(mx, __shfl_xor(mx, 32));
        float l = 0.f;
#pragma unroll
        for (int jt = 0; jt < 10; ++jt)
#pragma unroll
            for (int rr = 0; rr < 4; ++rr) { const float v = s[jt][rr]; const float pe = (v == -INFINITY) ? 0.f : __expf(v - mx); s[jt][rr] = pe; l += pe; }
        l += __shfl_xor(l, 16); l += __shfl_xor(l, 32); l += __expf(sink - mx);
        const float inv = 1.f / l;
        bf16x8 pf[5];
#pragma unroll
        for (int kp = 0; kp < 5; ++kp) pf[kp] = packf8(s[2 * kp] * inv, s[2 * kp + 1] * inv);
        f32x4 o[4];
#pragma unroll
        for (int dt = 0; dt < 4; ++dt) o[dt] = (f32x4){0.f, 0.f, 0.f, 0.f};
#pragma unroll
        for (int kp = 0; kp < 5; ++kp) { const LAS unsigned char* va = Vimg + (16 * (jt0 + 2 * kp) + 4 * g + q) * PV + p * 8;
#pragma unroll
            for (int dt = 0; dt < 4; ++dt) o[dt] = MFMA16(cat8(trrd(va + dt * 32), trrd(va + 16 * PV + dt * 32)), pf[kp], o[dt]); }
#pragma unroll
        for (int dt = 0; dt < 4; ++dt) *(v2u*)(SWA + (t0 + i) * 1536 + hq * 64 + 16 * dt + 4 * g) = packf4(o[dt] * vis1());
    }
    __syncthreads();
}

__device__ __forceinline__ void ret_unit(LAS unsigned char* lds, const bf16* QR, const bf16* KR, const bf16* VR, const bf16* GR, const bf16* ST, bf16* RET, int unit, int tid, int lane, int wid) {
    constexpr int PKR = 272, PS = 272, PBV = 544;
    LAS unsigned char* Kimg = lds; LAS unsigned char* Ximg = lds + 128 * PKR;
    const int n = unit & 63, bh = unit >> 6, b = bh >> 2, h = bh & 3;
    const float lg2 = log2f(1.f - exp2f(-5.f - (float)h));
    const size_t t0 = (size_t)b * SEQ + n * 128;
    const int c16 = lane & 15, g = lane >> 4, q = c16 >> 2, p = c16 & 3, i = 16 * wid + c16;
#pragma unroll
    for (int it = 0; it < 4; ++it) { const int c = tid + it * NTHR, j = c >> 4, ch = c & 15;
        *(LAS v4u*)(Kimg + j * PKR + ch * 16) = *(const v4u*)(KR + (t0 + j) * 512 + h * 128 + ch * 8); }
#pragma unroll
    for (int it = 0; it < 8; ++it) { const int c = tid + it * NTHR, e = c >> 4, ch = c & 15;
        *(LAS v4u*)(Ximg + e * PS + ch * 16) = *(const v4u*)(ST + ((size_t)unit * 256 + e) * 128 + ch * 8); }
    bf16x8 qf[4];
#pragma unroll
    for (int ks = 0; ks < 4; ++ks) qf[ks] = *(const bf16x8*)(QR + (t0 + i) * 512 + h * 128 + 32 * ks + 8 * g);
    __syncthreads();
    f32x4 s1[8];
#pragma unroll
    for (int jt = 0; jt < 8; ++jt) { s1[jt] = (f32x4){0.f, 0.f, 0.f, 0.f};
        if (jt <= wid) {
#pragma unroll
            for (int ks = 0; ks < 4; ++ks) { const bf16x8 A = *(const LAS bf16x8*)(Kimg + (16 * jt + c16) * PKR + (32 * ks + 8 * g) * 2); s1[jt] = MFMA16(A, qf[ks], s1[jt]); }
#pragma unroll
            for (int rr = 0; rr < 4; ++rr) { const int j = 16 * jt + 4 * g + rr; s1[jt][rr] = (i >= j) ? s1[jt][rr] * __builtin_amdgcn_exp2f((float)(i - j) * lg2) : 0.f; }
        } }
    bf16x8 pf[4];
#pragma unroll
    for (int kp = 0; kp < 4; ++kp) pf[kp] = packf8(s1[2 * kp], s1[2 * kp + 1]);
    f32x4 acc[16];
    const float sc = exp2f((float)(i + 1) * lg2);
#pragma unroll
    for (int et = 0; et < 16; ++et) { acc[et] = (f32x4){0.f, 0.f, 0.f, 0.f};
#pragma unroll
        for (int ks = 0; ks < 4; ++ks) { const bf16x8 A = *(const LAS bf16x8*)(Ximg + (16 * et + c16) * PS + (32 * ks + 8 * g) * 2); acc[et] = MFMA16(A, qf[ks], acc[et]); }
        acc[et] = acc[et] * sc; }
    __syncthreads();
#pragma unroll
    for (int it = 0; it < 8; ++it) { const int c = tid + it * NTHR, j = c >> 5, ch = c & 31;
        *(LAS v4u*)(Ximg + j * PBV + ch * 16) = *(const v4u*)(VR + (t0 + j) * 1024 + h * 256 + ch * 8); }
    __syncthreads();
#pragma unroll
    for (int kp = 0; kp < 4; ++kp) {
        if (2 * kp <= wid) { const LAS unsigned char* va = Ximg + (32 * kp + 4 * g + q) * PBV + p * 8;
#pragma unroll
            for (int et = 0; et < 16; ++et) acc[et] = MFMA16(cat8(trrd(va + et * 32), trrd(va + 16 * PBV + et * 32)), pf[kp], acc[et]); } }
    float sm = 0.f;
#pragma unroll
    for (int et = 0; et < 16; ++et) sm += (acc[et][0] + acc[et][1]) + (acc[et][2] + acc[et][3]);
    sm += __shfl_xor(sm, 16); sm += __shfl_xor(sm, 32);
    const float mean = sm * (1.f / 256.f); float sq = 0.f;
#pragma unroll
    for (int et = 0; et < 16; ++et) { acc[et] = acc[et] - mean; sq += (acc[et][0] * acc[et][0] + acc[et][1] * acc[et][1]) + (acc[et][2] * acc[et][2] + acc[et][3] * acc[et][3]); }
    sq += __shfl_xor(sq, 16); sq += __shfl_xor(sq, 32);
    const float rstd = rsqrtf(sq * (1.f / 256.f) + EPS);
#pragma unroll
    for (int et = 0; et < 16; ++et) { const size_t oi = (t0 + i) * 1024 + h * 256 + 16 * et + 4 * g;
        const f32x4 gt = unpk4(*(const v2u*)(GR + oi)); *(v2u*)(RET + oi + (t0 + i) * 512) = packf4(acc[et] * rstd * gt); }
    __syncthreads();
}

__device__ __forceinline__ float lg2gamma(int h) { return log2f(1.f - exp2f(-5.f - (float)h)); }

__device__ __forceinline__ void kv_load(const bf16* KR, const bf16* VR, int unit, int tid, v4u (&kreg)[4], v4u (&vreg)[8]) {
    const int n = unit & 63, bh = unit >> 6, b = bh >> 2, h = bh & 3; const size_t t0 = (size_t)b * SEQ + n * 128;
#pragma unroll
    for (int it = 0; it < 4; ++it) { const int c = tid + it * NTHR, j = c >> 4, ch = c & 15; kreg[it] = *(const v4u*)(KR + (t0 + j) * 512 + h * 128 + ch * 8); }
#pragma unroll
    for (int it = 0; it < 8; ++it) { const int c = tid + it * NTHR, j = c >> 5, ch = c & 31; vreg[it] = *(const v4u*)(VR + (t0 + j) * 1024 + h * 256 + ch * 8); }
}
__device__ __forceinline__ void kv_phase(LAS unsigned char* lds, const bf16* KR, const bf16* VR, bf16* ST, int first, int stride, int tid_, int lane_, int wid) {
    constexpr int PBK = 288, PBV = 544;
    LAS unsigned char* Kimg = lds; LAS unsigned char* Vimg = lds + 128 * PBK;
    v4u kreg[4], vreg[8];
    if (first < 1024) kv_load(KR, VR, first, tid_, kreg, vreg);
#pragma unroll 1
    for (int unit = first; unit < 1024; unit += stride) {
        const int h = (unit >> 6) & 3; const float lg2 = lg2gamma(h);
        int tid = tid_, lane = lane_; asm volatile("" : "+v"(tid), "+v"(lane));
        const int c16 = lane & 15, g = lane >> 4, q = c16 >> 2, p = c16 & 3;
#pragma unroll
        for (int it = 0; it < 4; ++it) { const int c = tid + it * NTHR, j = c >> 4, ch = c & 15; const v4u w = kreg[it]; const float dec = exp2f((float)(127 - j) * lg2);
            const f32x4 a = unpk4((v2u){w.x, w.y}) * dec, bb = unpk4((v2u){w.z, w.w}) * dec;
            *(LAS bf16x8*)(Kimg + j * PBK + ch * 16) = packf8(a, bb); }
#pragma unroll
        for (int it = 0; it < 8; ++it) { const int c = tid + it * NTHR, j = c >> 5, ch = c & 31; *(LAS v4u*)(Vimg + j * PBV + ch * 16) = vreg[it]; }
        __syncthreads();
        if (unit + stride < 1024) kv_load(KR, VR, unit + stride, tid, kreg, vreg);
        f32x4 acc[8][2];
#pragma unroll
        for (int dt = 0; dt < 8; ++dt) { acc[dt][0] = (f32x4){0.f, 0.f, 0.f, 0.f}; acc[dt][1] = (f32x4){0.f, 0.f, 0.f, 0.f}; }
#pragma unroll
        for (int ks = 0; ks < 4; ++ks) {
            const LAS unsigned char* ka = Kimg + (32 * ks + 4 * g + q) * PBK + p * 8;
            const LAS unsigned char* va = Vimg + (32 * ks + 4 * g + q) * PBV + p * 8 + wid * 64;
            bf16x8 B[2];
#pragma unroll
            for (int et = 0; et < 2; ++et) B[et] = cat8(trrd(va + et * 32), trrd(va + 16 * PBV + et * 32));
#pragma unroll
            for (int dt = 0; dt < 8; ++dt) { const bf16x8 A = cat8(trrd(ka + dt * 32), trrd(ka + 16 * PBK + dt * 32));
                acc[dt][0] = MFMA16(A, B[0], acc[dt][0]); acc[dt][1] = MFMA16(A, B[1], acc[dt][1]); }
        }
#pragma unroll
        for (int dt = 0; dt < 8; ++dt)
#pragma unroll
            for (int et = 0; et < 2; ++et) *(v2u*)(ST + ((size_t)unit * 256 + 32 * wid + 16 * et + c16) * 128 + 16 * dt + 4 * g) = packf4(acc[dt][et] * vis1());
        __syncthreads();
    }
}

__device__ __forceinline__ void swa_load(const bf16* KVS, int unit, int tid, v4u (&kreg)[4], v4u (&vreg)[4]) {
    const int g2 = unit & 1, n = (unit >> 1) & 63, b = unit >> 7; const size_t t0 = (size_t)b * SEQ + n * 128;
#pragma unroll
    for (int it = 0; it < 4; ++it) { const int c = tid + it * NTHR, j = c >> 3, ch = c & 7;
        kreg[it] = (v4u){0u, 0u, 0u, 0u}; vreg[it] = (v4u){0u, 0u, 0u, 0u};
        if (n > 0 || j >= 128) { const bf16* src = KVS + (t0 + j - 128) * 256 + g2 * 64 + ch * 8; kreg[it] = *(const v4u*)src; vreg[it] = *(const v4u*)(src + 128); } }
}
__device__ __forceinline__ void swa_phase(LAS unsigned char* lds, const bf16* QS, const bf16* KVS, const float* sinks, bf16* SWA, int first, int stride, int tid_, int lane_, int wid) {
    constexpr int PK = 144, PV = 160;
    LAS unsigned char* Kimg = lds; LAS unsigned char* Vimg = lds + 256 * PK;
    const int jt0 = 2 * (wid >> 1);
    v4u kreg[4], vreg[4];
    if (first < 512) swa_load(KVS, first, tid_, kreg, vreg);
#pragma unroll 1
    for (int unit = first; unit < 512; unit += stride) {
        const int g2 = unit & 1, n = (unit >> 1) & 63, b = unit >> 7; const size_t t0 = (size_t)b * SEQ + n * 128;
        int tid = tid_, lane = lane_; asm volatile("" : "+v"(tid), "+v"(lane));
        const int c16 = lane & 15, g = lane >> 4, q = c16 >> 2, p = c16 & 3, i = 16 * wid + c16;
#pragma unroll
        for (int it = 0; it < 4; ++it) { const int c = tid + it * NTHR, j = c >> 3, ch = c & 7; *(LAS v4u*)(Kimg + j * PK + ch * 16) = kreg[it]; *(LAS v4u*)(Vimg + j * PV + ch * 16) = vreg[it]; }
        bf16x8 qf[4][2];
#pragma unroll
        for (int r = 0; r < 4; ++r)
#pragma unroll
            for (int ks = 0; ks < 2; ++ks) qf[r][ks] = *(const bf16x8*)(QS + (t0 + i) * 512 + (g2 * 4 + r) * 64 + 32 * ks + 8 * g);
        __syncthreads();
        if (unit + stride < 512) swa_load(KVS, unit + stride, tid, kreg, vreg);
#pragma unroll
        for (int r = 0; r < 4; ++r) {
            const int hq = g2 * 4 + r;
            const float slope = exp2f(-(float)(hq + 1)), sink = sinks[hq];
            f32x4 s[10];
#pragma unroll
            for (int jt = 0; jt < 10; ++jt) { s[jt] = (f32x4){0.f, 0.f, 0.f, 0.f};
#pragma unroll
                for (int ks = 0; ks < 2; ++ks) { const bf16x8 A = *(const LAS bf16x8*)(Kimg + (16 * (jt0 + jt) + c16) * PK + (32 * ks + 8 * g) * 2); s[jt] = MFMA16(A, qf[r][ks], s[jt]); } }
            float mx = sink;
#pragma unroll
            for (int jt = 0; jt < 10; ++jt)
#pragma unroll
                for (int rr = 0; rr < 4; ++rr) { const int j = 16 * (jt0 + jt) + 4 * g + rr, dist = i + 128 - j;
                    const bool valid = dist >= 0 && dist < 128 && (n > 0 || j >= 128);
                    const float v = valid ? s[jt][rr] - slope * (float)dist : -INFINITY; s[jt][rr] = v; mx = fmaxf(mx, v); }
            mx = fmaxf(mx, __shfl_xor(mx, 16)); mx = fmaxf(mx, __shfl_xor(mx, 32));
            float l = 0.f;
#pragma unroll
            for (int jt = 0; jt < 10; ++jt)
#pragma unroll
                for (int rr = 0; rr < 4; ++rr) { const float v = s[jt][rr]; const float pe = (v == -INFINITY) ? 0.f : __expf(v - mx); s[jt][rr] = pe; l += pe; }
            l += __shfl_xor(l, 16); l += __shfl_xor(l, 32); l += __expf(sink - mx);
            const float inv = 1.f / l;
            bf16x8 pf[5];
#pragma unroll
            for (int kp = 0; kp < 5; ++kp) pf[kp] = packf8(s[2 * kp] * inv, s[2 * kp + 1] * inv);
            f32x4 o[4];
#pragma unroll
            for (int dt = 0; dt < 4; ++dt) o[dt] = (f32x4){0.f, 0.f, 0.f, 0.f};
#pragma unroll
            for (int kp = 0; kp < 5; ++kp) { const LAS unsigned char* va = Vimg + (16 * (jt0 + 2 * kp) + 4 * g + q) * PV + p * 8;
#pragma unroll
                for (int dt = 0; dt < 4; ++dt) o[dt] = MFMA16(cat8(trrd(va + dt * 32), trrd(va + 16 * PV + dt * 32)), pf[kp], o[dt]); }
#pragma unroll
            for (int dt = 0; dt < 4; ++dt) *(v2u*)(SWA + (t0 + i) * 1536 + hq * 64 + 16 * dt + 4 * g) = packf4(o[dt] * vis1());
        }
        __syncthreads();
    }
}

__device__ __forceinline__ void ret_load(const bf16* KR, const bf16* ST, int unit, int tid, v4u (&kreg)[4], v4u (&sreg)[8]) {
    const int n = unit & 63, bh = unit >> 6, b = bh >> 2, h = bh & 3; const size_t t0 = (size_t)b * SEQ + n * 128;
#pragma unroll
    for (int it = 0; it < 4; ++it) { const int c = tid + it * NTHR, j = c >> 4, ch = c & 15; kreg[it] = *(const v4u*)(KR + (t0 + j) * 512 + h * 128 + ch * 8); }
#pragma unroll
    for (int it = 0; it < 8; ++it) { const int c = tid + it * NTHR; sreg[it] = *(const v4u*)(ST + (size_t)unit * 32768 + (size_t)c * 8); }
}
__device__ __forceinline__ void ret_phase(LAS unsigned char* lds, const bf16* QR, const bf16* KR, const bf16* VR, const bf16* GR, const bf16* ST, bf16* RET, int first, int stride, int tid_, int lane_, int wid) {
    constexpr int PKR = 272, PS = 272, PBV = 544;
    LAS unsigned char* Kimg = lds; LAS unsigned char* Ximg = lds + 128 * PKR;
    v4u kreg[4], sreg[8];
    if (first < 1024) ret_load(KR, ST, first, tid_, kreg, sreg);
#pragma unroll 1
    for (int unit = first; unit < 1024; unit += stride) {
        const int n = unit & 63, bh = unit >> 6, b = bh >> 2, h = bh & 3;
        const float lg2 = lg2gamma(h);
        const size_t t0 = (size_t)b * SEQ + n * 128;
        int tid = tid_, lane = lane_; asm volatile("" : "+v"(tid), "+v"(lane));
        const int c16 = lane & 15, g = lane >> 4, q = c16 >> 2, p = c16 & 3, i = 16 * wid + c16;
#pragma unroll
        for (int it = 0; it < 4; ++it) { const int c = tid + it * NTHR, j = c >> 4, ch = c & 15; *(LAS v4u*)(Kimg + j * PKR + ch * 16) = kreg[it]; }
#pragma unroll
        for (int it = 0; it < 8; ++it) { const int c = tid + it * NTHR, e = c >> 4, ch = c & 15; *(LAS v4u*)(Ximg + e * PS + ch * 16) = sreg[it]; }
        bf16x8 qf[4];
#pragma unroll
        for (int ks = 0; ks < 4; ++ks) qf[ks] = *(const bf16x8*)(QR + (t0 + i) * 512 + h * 128 + 32 * ks + 8 * g);
        __syncthreads();
        v4u vreg[8];
#pragma unroll
        for (int it = 0; it < 8; ++it) { const int c = tid + it * NTHR, j = c >> 5, ch = c & 31; vreg[it] = *(const v4u*)(VR + (t0 + j) * 1024 + h * 256 + ch * 8); }
        f32x4 s1[8];
#pragma unroll
        for (int jt = 0; jt < 8; ++jt) { s1[jt] = (f32x4){0.f, 0.f, 0.f, 0.f};
            if (jt <= wid) {
#pragma unroll
                for (int ks = 0; ks < 4; ++ks) { const bf16x8 A = *(const LAS bf16x8*)(Kimg + (16 * jt + c16) * PKR + (32 * ks + 8 * g) * 2); s1[jt] = MFMA16(A, qf[ks], s1[jt]); }
#pragma unroll
                for (int rr = 0; rr < 4; ++rr) { const int j = 16 * jt + 4 * g + rr; s1[jt][rr] = (i >= j) ? s1[jt][rr] * __builtin_amdgcn_exp2f((float)(i - j) * lg2) : 0.f; }
            } }
        bf16x8 pf[4];
#pragma unroll
        for (int kp = 0; kp < 4; ++kp) pf[kp] = packf8(s1[2 * kp], s1[2 * kp + 1]);
        f32x4 acc[16];
        const float sc = exp2f((float)(i + 1) * lg2);
#pragma unroll
        for (int et = 0; et < 16; ++et) { acc[et] = (f32x4){0.f, 0.f, 0.f, 0.f};
#pragma unroll
            for (int ks = 0; ks < 4; ++ks) { const bf16x8 A = *(const LAS bf16x8*)(Ximg + (16 * et + c16) * PS + (32 * ks + 8 * g) * 2); acc[et] = MFMA16(A, qf[ks], acc[et]); }
            acc[et] = acc[et] * sc; if (et & 1) __builtin_amdgcn_sched_barrier(0); }
        __syncthreads();
#pragma unroll
        for (int it = 0; it < 8; ++it) { const int c = tid + it * NTHR, j = c >> 5, ch = c & 31; *(LAS v4u*)(Ximg + j * PBV + ch * 16) = vreg[it]; }
        if (unit + stride < 1024) ret_load(KR, ST, unit + stride, tid, kreg, sreg);
        __syncthreads();
#pragma unroll
        for (int kp = 0; kp < 4; ++kp) {
            if (2 * kp <= wid) { const LAS unsigned char* va = Ximg + (32 * kp + 4 * g + q) * PBV + p * 8;
#pragma unroll
                for (int et = 0; et < 16; ++et) { acc[et] = MFMA16(cat8(trrd(va + et * 32), trrd(va + 16 * PBV + et * 32)), pf[kp], acc[et]); if ((et & 3) == 3) __builtin_amdgcn_sched_barrier(0); } } }
        int tidg = tid; asm volatile("" : "+v"(tidg));
        v4u gtv[8];
#pragma unroll
        for (int k = 0; k < 8; ++k) { const int id = tidg + k * NTHR; gtv[k] = *(const v4u*)(GR + (t0 + (id >> 5)) * 1024 + h * 256 + (id & 31) * 8); }
        float sm = 0.f;
#pragma unroll
        for (int et = 0; et < 16; ++et) sm += (acc[et][0] + acc[et][1]) + (acc[et][2] + acc[et][3]);
        sm += __shfl_xor(sm, 16); sm += __shfl_xor(sm, 32);
        const float mean = sm * (1.f / 256.f); float sq = 0.f;
#pragma unroll
        for (int et = 0; et < 16; ++et) { acc[et] = acc[et] - mean; sq += (acc[et][0] * acc[et][0] + acc[et][1] * acc[et][1]) + (acc[et][2] * acc[et][2] + acc[et][3] * acc[et][3]); }
        sq += __shfl_xor(sq, 16); sq += __shfl_xor(sq, 32);
        const float rstd = rsqrtf(sq * (1.f / 256.f) + EPS);
        __syncthreads();
        {
            constexpr int PO = 528;
#pragma unroll
            for (int et = 0; et < 16; ++et) *(LAS v2u*)(Ximg + i * PO + (16 * et + 4 * g) * 2) = packf4(acc[et] * rstd);
            __syncthreads();
            int tid2 = tid; asm volatile("" : "+v"(tid2));
#pragma unroll
            for (int k = 0; k < 8; ++k) { const int id = tid2 + k * NTHR, row = id >> 5, ch = id & 31;
                const v4u o = *(const LAS v4u*)(Ximg + row * PO + ch * 16); const v4u gq = gtv[k];
                const f32x4 y0 = unpk4((v2u){o.x, o.y}) * unpk4((v2u){gq.x, gq.y}), y1 = unpk4((v2u){o.z, o.w}) * unpk4((v2u){gq.z, gq.w});
                const v2u a0 = packf4(y0), a1 = packf4(y1);
                *(v4u*)(RET + (t0 + row) * 1536 + h * 256 + ch * 8) = (v4u){a0.x, a0.y, a1.x, a1.y}; }
        }
        __syncthreads();
    }
}

__device__ __forceinline__ void p2_load(const bf16* KR, const bf16* VR, const bf16* KVS, int it, int tid, v4u (&r)[12]) {
    if (it < 1024) {
        const int unit = it, n = unit & 63, bh = unit >> 6, b = bh >> 2, h = bh & 3; const size_t t0 = (size_t)b * SEQ + n * 128;
#pragma unroll
        for (int k = 0; k < 4; ++k) { const int c = tid + k * NTHR, j = c >> 4, ch = c & 15; r[k] = *(const v4u*)(KR + (t0 + j) * 512 + h * 128 + ch * 8); }
#pragma unroll
        for (int k = 0; k < 8; ++k) { const int c = tid + k * NTHR, j = c >> 5, ch = c & 31; r[4 + k] = *(const v4u*)(VR + (t0 + j) * 1024 + h * 256 + ch * 8); }
    } else {
        const int unit = it - 1024, g2 = unit & 1, n = (unit >> 1) & 63, b = unit >> 7; const size_t t0 = (size_t)b * SEQ + n * 128;
#pragma unroll
        for (int k = 0; k < 4; ++k) { const int c = tid + k * NTHR, j = c >> 3, ch = c & 7;
            r[k] = (v4u){0u, 0u, 0u, 0u}; r[4 + k] = (v4u){0u, 0u, 0u, 0u};
            if (n > 0 || j >= 128) { const bf16* s = KVS + (t0 + j - 128) * 256 + g2 * 64 + ch * 8; r[k] = *(const v4u*)s; r[4 + k] = *(const v4u*)(s + 128); } }
    }
}
__device__ __forceinline__ void p2_phase(LAS unsigned char* lds, const bf16* KR, const bf16* VR, bf16* ST, const bf16* QS, const bf16* KVS, const float* sinks, bf16* SWA, int first, int stride, int tid_, int lane_, int wid) {
    v4u r[12];
    if (first < 1536) p2_load(KR, VR, KVS, first, tid_, r);
#pragma unroll 1
    for (int it = first; it < 1536; it += stride) {
        int tid = tid_, lane = lane_; asm volatile("" : "+v"(tid), "+v"(lane));
        const int c16 = lane & 15, g = lane >> 4, q = c16 >> 2, p = c16 & 3;
        if (it < 1024) {
            constexpr int PBK = 288, PBV = 544;
            LAS unsigned char* Kimg = lds; LAS unsigned char* Vimg = lds + 128 * PBK;
            const int unit = it, h = (unit >> 6) & 3; const float lg2 = lg2gamma(h);
#pragma unroll
            for (int k = 0; k < 4; ++k) { const int c = tid + k * NTHR, j = c >> 4, ch = c & 15; const v4u w = r[k]; const float dec = exp2f((float)(127 - j) * lg2);
                const f32x4 a = unpk4((v2u){w.x, w.y}) * dec, bb = unpk4((v2u){w.z, w.w}) * dec;
                *(LAS bf16x8*)(Kimg + j * PBK + ch * 16) = packf8(a, bb); }
#pragma unroll
            for (int k = 0; k < 8; ++k) { const int c = tid + k * NTHR, j = c >> 5, ch = c & 31; *(LAS v4u*)(Vimg + j * PBV + ch * 16) = r[4 + k]; }
            __syncthreads();
            if (it + stride < 1536) p2_load(KR, VR, KVS, it + stride, tid, r);
            f32x4 acc[8][2];
#pragma unroll
            for (int dt = 0; dt < 8; ++dt) { acc[dt][0] = (f32x4){0.f, 0.f, 0.f, 0.f}; acc[dt][1] = (f32x4){0.f, 0.f, 0.f, 0.f}; }
#pragma unroll
            for (int ks = 0; ks < 4; ++ks) {
                const LAS unsigned char* ka = Kimg + (32 * ks + 4 * g + q) * PBK + p * 8;
                const LAS unsigned char* va = Vimg + (32 * ks + 4 * g + q) * PBV + p * 8 + wid * 64;
                bf16x8 B[2];
#pragma unroll
                for (int et = 0; et < 2; ++et) B[et] = cat8(trrd(va + et * 32), trrd(va + 16 * PBV + et * 32));
#pragma unroll
                for (int dt = 0; dt < 8; ++dt) { const bf16x8 A = cat8(trrd(ka + dt * 32), trrd(ka + 16 * PBK + dt * 32));
                    acc[dt][0] = MFMA16(A, B[0], acc[dt][0]); acc[dt][1] = MFMA16(A, B[1], acc[dt][1]); }
            }
            __syncthreads();
            {
                constexpr int PT = 272;
#pragma unroll
                for (int dt = 0; dt < 8; ++dt)
#pragma unroll
                    for (int et = 0; et < 2; ++et) *(LAS v2u*)(lds + (32 * wid + 16 * et + c16) * PT + (16 * dt + 4 * g) * 2) = packf4(acc[dt][et] * vis1());
                __syncthreads();
#pragma unroll
                for (int k = 0; k < 8; ++k) { const int id = tid + k * NTHR; *(v4u*)(ST + (size_t)unit * 32768 + (size_t)id * 8) = *(const LAS v4u*)(lds + (id >> 4) * PT + (id & 15) * 16); }
            }
            __syncthreads();
        } else {
            constexpr int PK = 144, PV = 160;
            LAS unsigned char* Kimg = lds; LAS unsigned char* Vimg = lds + 256 * PK;
            const int unit = it - 1024, g2 = unit & 1, n = (unit >> 1) & 63, b = unit >> 7; const size_t t0 = (size_t)b * SEQ + n * 128;
            const int jt0 = 2 * (wid >> 1), i = 16 * wid + c16;
#pragma unroll
            for (int k = 0; k < 4; ++k) { const int c = tid + k * NTHR, j = c >> 3, ch = c & 7; *(LAS v4u*)(Kimg + j * PK + ch * 16) = r[k]; *(LAS v4u*)(Vimg + j * PV + ch * 16) = r[4 + k]; }
            bf16x8 qfa[4][2];
#pragma unroll
            for (int rh = 0; rh < 4; ++rh)
#pragma unroll
                for (int ks = 0; ks < 2; ++ks) qfa[rh][ks] = *(const bf16x8*)(QS + (t0 + i) * 512 + (g2 * 4 + rh) * 64 + 32 * ks + 8 * g);
            __syncthreads();
            if (it + stride < 1536) p2_load(KR, VR, KVS, it + stride, tid, r);
#pragma unroll
            for (int rh = 0; rh < 4; ++rh) {
                const int hq = g2 * 4 + rh;
                const float slope = exp2f(-(float)(hq + 1)), sink = sinks[hq];
                bf16x8 qf[2]; qf[0] = qfa[rh][0]; qf[1] = qfa[rh][1];
                f32x4 s[10];
#pragma unroll
                for (int jt = 0; jt < 10; ++jt) { s[jt] = (f32x4){0.f, 0.f, 0.f, 0.f};
#pragma unroll
                    for (int ks = 0; ks < 2; ++ks) { const bf16x8 A = *(const LAS bf16x8*)(Kimg + (16 * (jt0 + jt) + c16) * PK + (32 * ks + 8 * g) * 2); s[jt] = MFMA16(A, qf[ks], s[jt]); } }
                float mx = sink;
#pragma unroll
                for (int jt = 0; jt < 10; ++jt)
#pragma unroll
                    for (int rr = 0; rr < 4; ++rr) { const int j = 16 * (jt0 + jt) + 4 * g + rr, dist = i + 128 - j;
                        const bool valid = dist >= 0 && dist < 128 && (n > 0 || j >= 128);
                        const float v = valid ? s[jt][rr] - slope * (float)dist : -INFINITY; s[jt][rr] = v; mx = fmaxf(mx, v); }
                mx = fmaxf(mx, __shfl_xor(mx, 16)); mx = fmaxf(mx, __shfl_xor(mx, 32));
                float l = 0.f;
#pragma unroll
                for (int jt = 0; jt < 10; ++jt)
#pragma unroll
                    for (int rr = 0; rr < 4; ++rr) { const float v = s[jt][rr]; const float pe = (v == -INFINITY) ? 0.f : __expf(v - mx); s[jt][rr] = pe; l += pe; }
                l += __shfl_xor(l, 16); l += __shfl_xor(l, 32); l += __expf(sink - mx);
                const float inv = 1.f / l;
                bf16x8 pf[5];
#pragma unroll
                for (int kp = 0; kp < 5; ++kp) pf[kp] = packf8(s[2 * kp] * inv, s[2 * kp + 1] * inv);
                f32x4 o[4];
#pragma unroll
                for (int dt = 0; dt < 4; ++dt) o[dt] = (f32x4){0.f, 0.f, 0.f, 0.f};
#pragma unroll
                for (int kp = 0; kp < 5; ++kp) { const LAS unsigned char* va = Vimg + (16 * (jt0 + 2 * kp) + 4 * g + q) * PV + p * 8;
#pragma unroll
                    for (int dt = 0; dt < 4; ++dt) o[dt] = MFMA16(cat8(trrd(va + dt * 32), trrd(va + 16 * PV + dt * 32)), pf[kp], o[dt]); }
#pragma unroll
                for (int dt = 0; dt < 4; ++dt) *(LAS v2u*)(lds + 77824 + i * 528 + (rh * 64 + 16 * dt + 4 * g) * 2) = packf4(o[dt] * vis1());
                __builtin_amdgcn_sched_barrier(0);
            }
            __syncthreads();
#pragma unroll
            for (int k = 0; k < 8; ++k) { const int id = tid + k * NTHR, row = id >> 5, ch = id & 31;
                *(v4u*)(SWA + (t0 + row) * 1536 + g2 * 256 + ch * 8) = *(const LAS v4u*)(lds + 77824 + row * 528 + ch * 16); }
            __syncthreads();
        }
    }
}
struct Args { const float* in[12]; float* out; unsigned char* ws; int ph_lo, ph_hi; };
constexpr int NPH = 9;
#ifndef PROBE_REP
#define PROBE_REP (-1)
#endif

__global__ void __launch_bounds__(NTHR, 2) mega(Args a) {
    extern __shared__ __attribute__((aligned(16))) unsigned char lds_raw[];
    LAS unsigned char* lds = (LAS unsigned char*)lds_raw;
    cg::grid_group grid = cg::this_grid();
    const int tid = threadIdx.x, lane = tid & 63, wid = __builtin_amdgcn_readfirstlane(tid >> 6);
    const int G = gridDim.x, gw = blockIdx.x * NWAVES + wid, NGW = G * NWAVES;
    unsigned char* ws = a.ws;
    const float* x = a.in[0]; const float* g_premix = a.in[1]; const float* sinks = a.in[6];
    const float* g_postmix = a.in[7]; const float* g_premlp = a.in[8]; const float* g_postmlp = a.in[11];
    bf16* Win_t = (bf16*)(ws + OFF_WIN); bf16* Wr_t = (bf16*)(ws + OFF_WR); bf16* Ws_t = (bf16*)(ws + OFF_WS); bf16* Wo_t = (bf16*)(ws + OFF_WO);
    bf16* Wup_t = (bf16*)(ws + OFF_WUP); bf16* Wdn_t = (bf16*)(ws + OFF_WDN);
    bf16* QR = (bf16*)(ws + OFF_QR); bf16* KR = (bf16*)(ws + OFF_KR); bf16* VR = (bf16*)(ws + OFF_VR); bf16* GR = (bf16*)(ws + OFF_GR);
    bf16* QS = (bf16*)(ws + OFF_QS); bf16* KVS = (bf16*)(ws + OFF_KVS); bf16* GTR = (bf16*)(ws + OFF_GTR); bf16* GTS = (bf16*)(ws + OFF_GTS);
    bf16* ST = (bf16*)(ws + OFF_ST); bf16* TB = (bf16*)(ws + OFF_T); bf16* MG = (bf16*)(ws + OFF_MG); float* Z = (float*)(ws + OFF_Z);
    bf16* H2 = (bf16*)(ws + OFF_H2); bf16* U = (bf16*)(ws + OFF_U); float* DD = (float*)(ws + OFF_DD);
    bf16* HB = (bf16*)a.out; bf16* RET = (bf16*)a.out; bf16* SWA = (bf16*)a.out + 1024;
    float* X1 = a.out; bf16* X1B = (bf16*)(ws + OFF_DD);
    unsigned* CNT = (unsigned*)ws; float* SL1 = (float*)(ws + 34 * MiB); float* SL2 = (float*)(ws + 34 * MiB + 512 * 1024); float* SL3 = (float*)(ws + 35 * MiB);
    const int lo = a.ph_lo, hi = a.ph_hi;
    volatile LAS unsigned* bst = (volatile LAS unsigned*)(lds + LDS_BYTES - 64);
    if (tid < 2) bst[tid] = 0u;
    __syncthreads();
    const XcdBarrier bar = xcd_barrier_post((unsigned*)ws + 24576, bst);
    if (a.ph_lo < 0) grid.sync();
#define IN(k) (lo <= (k) && (k) < hi)
#define SEAM(k) do { if (IN(k) && IN((k) + 1)) { xcd_barrier(bar); } } while (0)

    if (IN(0)) {
        LAS float* scr = (LAS float*)(lds + wid * 16384);
        constexpr int I0 = 16 * 184, I1 = 16 * 32, I2 = 8 * 32, I3 = 16 * 32, I4 = 16 * 128, I5 = 64 * 32, NIT = I0 + I1 + I2 + I3;
        for (int it = gw; it < NIT; it += NGW) {
            int r = it;
            if (r < I0) { p0_transpose_item(a.in[2], 1024, DIN, Win_t, scr, r, lane); continue; } r -= I0;
            if (r < I1) { p0_transpose_item(a.in[3], 1024, 1024, Wr_t, scr, r, lane, 1536, 0); continue; } r -= I1;
            if (r < I2) { p0_transpose_item(a.in[4], 512, 1024, Wr_t, scr, r, lane, 1536, 1024); continue; } r -= I2;
            p0_transpose_item(a.in[5], 1024, 1024, Wo_t, scr, r, lane);
        }
        for (int m0 = gw; m0 < M; m0 += 2 * NGW) {
            const int m1 = (m0 + NGW < M) ? m0 + NGW : m0;
            const f32x4* xr0 = (const f32x4*)(x + (size_t)m0 * D) + lane; const f32x4* xr1 = (const f32x4*)(x + (size_t)m1 * D) + lane; f32x4 v0[4], v1[4]; float s0 = 0.f, s1 = 0.f;
#pragma unroll
            for (int j = 0; j < 4; ++j) { v0[j] = xr0[64 * j]; v1[j] = xr1[64 * j]; }
#pragma unroll
            for (int j = 0; j < 4; ++j) { s0 += (v0[j].x * v0[j].x + v0[j].y * v0[j].y) + (v0[j].z * v0[j].z + v0[j].w * v0[j].w); s1 += (v1[j].x * v1[j].x + v1[j].y * v1[j].y) + (v1[j].z * v1[j].z + v1[j].w * v1[j].w); }
            const float rs0 = rsqrtf(wave_sum(s0) * (1.f / D) + EPS), rs1 = rsqrtf(wave_sum(s1) * (1.f / D) + EPS);
            unsigned long long* o80 = (unsigned long long*)(HB + (size_t)m0 * D) + lane; unsigned long long* o81 = (unsigned long long*)(HB + (size_t)m1 * D) + lane;
#pragma unroll
            for (int j = 0; j < 4; ++j) { const f32x4 g = ((const f32x4*)g_premix)[lane + 64 * j]; const f32x4 a0 = v0[j] * rs0 * g, a1 = v1[j] * rs1 * g;
                o80[64 * j] = (unsigned long long)pk2(a0.x, a0.y) | ((unsigned long long)pk2(a0.z, a0.w) << 32);
                o81[64 * j] = (unsigned long long)pk2(a1.x, a1.y) | ((unsigned long long)pk2(a1.z, a1.w) << 32); }
        }
    }
    SEAM(0);
    if (IN(1)) {
        pg8::Gemm g{HB, Win_t, M, DIN, 1024}; pg8::StaticOrder S; S.init(M, DIN, G, (int)blockIdx.x);
        pg8::EpiB<0> E{ws, nullptr, 0, nullptr, nullptr};
        pg8::gemm_phase<pg8::EpiB<0>, pg8::StaticOrder, true, true>(lds, g, S, E);
        {
            constexpr int I4 = 16 * 128, I5 = 64 * 32, NU = (M / 256) * (DIN / 256);
            const int nfull = NU / G, rem = NU - nfull * G;
            const int nidle = G - rem;
            if (rem > 0 && (int)blockIdx.x >= rem) {
                __syncthreads();
                LAS float* scr = (LAS float*)(lds + wid * 16384);
                for (int it = ((int)blockIdx.x - rem) * NWAVES + wid; it < I4 + I5; it += nidle * NWAVES) {
                    if (it < I4) p0_transpose_item(a.in[9], 1024, FF, Wup_t, scr, it, lane);
                    else p0_transpose_item(a.in[10], FF, 1024, Wdn_t, scr, it - I4, lane);
                }
            } else if (rem == 0) {
                __syncthreads();
                LAS float* scr = (LAS float*)(lds + wid * 16384);
                for (int it = gw; it < I4 + I5; it += NGW) {
                    if (it < I4) p0_transpose_item(a.in[9], 1024, FF, Wup_t, scr, it, lane);
                    else p0_transpose_item(a.in[10], FF, 1024, Wdn_t, scr, it - I4, lane);
                }
            }
        }
    }
    SEAM(1);
    if (IN(2)) {
        p2_phase(lds, KR, VR, ST, QS, KVS, sinks, SWA, (int)blockIdx.x, G, tid, lane, wid);
    }
    SEAM(2);
    if (IN(3)) {
        for (int idx = blockIdx.x * NTHR + tid; idx < 16 * 256 * 32; idx += G * NTHR) {
            const int d4 = idx & 31, e = (idx >> 5) & 255, bh = idx >> 13, h = bh & 3;
            const float cd = exp2f(128.f * log2f(1.f - exp2f(-5.f - (float)h)));
            bf16* p = ST + ((size_t)(bh * 64) * 256 + e) * 128 + d4 * 4;
            f32x4 s = (f32x4){0.f, 0.f, 0.f, 0.f};
#pragma unroll 1
            for (int n0 = 0; n0 < 64; n0 += 16) {
                v2u w[16];
#pragma unroll
                for (int u = 0; u < 16; ++u) w[u] = *(const v2u*)(p + (size_t)(n0 + u) * 32768);
#pragma unroll
                for (int u = 0; u < 16; ++u) { *(v2u*)(p + (size_t)(n0 + u) * 32768) = packf4(s); s = s * cd + unpk4(w[u]); }
            }
        }
    }
    SEAM(3);
    if (IN(4)) {
#if USE_NEW_RET
        ret_phase(lds, QR, KR, VR, GR, ST, RET, (int)blockIdx.x, G, tid, lane, wid);
#else
        for (int unit = blockIdx.x; unit < 1024; unit += G) ret_unit(lds, QR, KR, VR, GR, ST, RET, unit, tid, lane, wid);
#endif
    }
    SEAM(4);
    if (IN(5)) {
        pg8::Gemm g{RET, Wr_t, M, 1024, 1536}; pg8::StaticOrder S; S.init(M, 1024, G, (int)blockIdx.x);
        pg8::EpiMerged E{MG, GTR, GTS};
        pg8::gemm_phase<pg8::EpiMerged, pg8::StaticOrder, true, true>(lds, g, S, E);
    }
    SEAM(5);
    if (IN(6)) {
#pragma unroll 1
        for (int pass = 0; pass < (512 + G - 1) / G; ++pass) {
            pg8::Gemm g{MG, Wo_t, M, 1024, 1024}; pg8::OneUnit S; S.base.init(M, 1024, G, (int)blockIdx.x); S.pass = pass;
            pg8::RowSq st1{SL1, CNT, EPS}, st2{SL2, CNT + 8192, EPS};
            pg8::EpiRmsResRms E{x, X1B, H2, g_postmix, g_premlp, st1, st2};
            pg8::gemm_phase<pg8::EpiRmsResRms, pg8::OneUnit, false, true>(lds, g, S, E);
            __syncthreads();
        }
    }
    SEAM(6);
    if (IN(7)) {
        pg8::Gemm g{H2, Wup_t, M, FF, 1024}; pg8::StaticOrder S; S.init(M, FF, G, (int)blockIdx.x);
        pg8::EpiB<3> E{ws, U, FF, nullptr, nullptr};
        pg8::gemm_phase<pg8::EpiB<3>, pg8::StaticOrder, true, true>(lds, g, S, E);
    }
    SEAM(7);
    if (IN(8)) {
#pragma unroll 1
        for (int pass = 0; pass < (512 + G - 1) / G; ++pass) {
            pg8::Gemm g{U, Wdn_t, M, 1024, FF}; pg8::OneUnit S; S.base.init(M, 1024, G, (int)blockIdx.x); S.pass = pass;
            pg8::RowSq st{SL3, CNT + 16384, EPS};
            pg8::EpiRmsRes E{X1B, X1, g_postmlp, st};
            pg8::gemm_phase<pg8::EpiRmsRes, pg8::OneUnit, false, true>(lds, g, S, E);
            __syncthreads();
        }
    }
#undef IN
#undef SEAM
}

extern "C" void kernel_launch(void* const* d_in, const int* in_sizes, int n_in, void* d_out, int out_size, void* d_ws, size_t ws_size, hipStream_t stream) {
    static int grid = 0;
    if (grid == 0) {
        if (n_in != 12 || in_sizes[0] != M * D || out_size != M * D || ws_size < WS_NEED) { fprintf(stderr, "kernel_launch: unexpected shapes (n_in %d, ws %zu)\n", n_in, ws_size); grid = -1; return; }
        int dev = 0, cus = 0, per_cu = 0;
        hipGetDevice(&dev); hipDeviceGetAttribute(&cus, hipDeviceAttributeMultiprocessorCount, dev);
        hipFuncSetAttribute((const void*)mega, hipFuncAttributeMaxDynamicSharedMemorySize, LDS_BYTES);
        hipOccupancyMaxActiveBlocksPerMultiprocessor(&per_cu, (const void*)mega, NTHR, LDS_BYTES);
        if (per_cu < 1) { fprintf(stderr, "kernel_launch: occupancy query says %d blocks/CU\n", per_cu); per_cu = 1; }
        (void)hipGetLastError();
        grid = cus * 1;
    }
    if (grid < 0) return;
    if (hipMemsetAsync(d_ws, 0, 128 * 1024, stream) != hipSuccess) { fprintf(stderr, "kernel_launch: memset failed\n"); return; }
    Args a{};
    for (int i = 0; i < 12; ++i) a.in[i] = (const float*)d_in[i];
    a.out = (float*)d_out; a.ws = (unsigned char*)d_ws; a.ph_lo = 0; a.ph_hi = NPH;
    void* args[] = {&a};
    hipError_t e = hipLaunchCooperativeKernel((const void*)mega, dim3(grid), dim3(NTHR), args, LDS_BYTES, stream);
    if (e != hipSuccess) fprintf(stderr, "cooperative launch failed: %s (grid %d)\n", hipGetErrorString(e), grid);
}
```

```cpp
#include <hip/hip_runtime.h>
#include <hip/hip_cooperative_groups.h>
#include <cstdio>
#include <cstdint>
namespace cg = cooperative_groups;

constexpr int M = 32768, D = 1024, DIN = 5888, FF = 4096, SEQ = 8192;
constexpr float EPS = 1e-6f;
constexpr size_t MiB = 1u << 20;
constexpr size_t OFF_WIN = 1 * MiB, OFF_WR = 13 * MiB, OFF_WS = 15 * MiB, OFF_WO = 16 * MiB, OFF_WUP = 18 * MiB, OFF_WDN = 26 * MiB;
constexpr size_t OFF_QR = 40 * MiB, OFF_KR = 72 * MiB, OFF_VR = 104 * MiB, OFF_GR = 168 * MiB, OFF_QS = 232 * MiB, OFF_KVS = 264 * MiB,
                 OFF_GTR = 280 * MiB, OFF_GTS = 344 * MiB, OFF_ST = 408 * MiB;
constexpr size_t OFF_T = 40 * MiB, OFF_MG = 104 * MiB, OFF_Z = 168 * MiB, OFF_H2 = 40 * MiB, OFF_U = 104 * MiB, OFF_DD = 360 * MiB, WS_NEED = 488 * MiB;
constexpr size_t OUT_SWA = 64 * MiB;
namespace pg8 {
#define PG8_LAS __attribute__((address_space(3)))
typedef unsigned short bf16_t;
typedef short bf16x8 __attribute__((ext_vector_type(8)));
typedef float f32x4 __attribute__((ext_vector_type(4)));
typedef unsigned u32x4 __attribute__((ext_vector_type(4)));
constexpr int BM = 256, BK = 64, HALF = 128, HTB = HALF * BK * 2  , STAGE_BYTES = 8 * HTB, NXCD = 8, WGM = 8;

__host__ __device__ __forceinline__ int lds_byte(int r, int c) { const int st = (r >> 4) * 2 + (c >> 5), rr = r & 15, cc = c & 31, ob = rr * 64 + cc * 2; return st * 1024 + (ob ^ (((ob >> 9) & 1) << 5)); }
__host__ __device__ __forceinline__ void stage_rc(int b, int& R, int& C) { const int st = b / 1024, sb = b % 1024, swz = sb ^ (((sb >> 9) & 1) << 5); R = (st >> 1) * 16 + swz / 64; C = (st & 1) * 32 + (swz % 64) / 2; }
__host__ __device__ __forceinline__ int perm32(int rho) { const int n = rho >> 4, i = rho & 15; return 8 * (i >> 2) + 4 * n + (i & 3); }

struct Unit { int pm, pn; };
struct Gemm { const bf16_t* A; const bf16_t* Bt; int M, N, K; };

struct StaticOrder {
    int nM, nN, nwg, G, c;
    __host__ __device__ void init(int M, int N, int G_, int c_) { nM = M / BM; nN = N / BM; nwg = nM * nN; G = G_; c = c_; }
    __host__ __device__ bool next(int i, Unit& u) const {
        const long L = (long)i * G + c; if (L >= nwg) return false;
        int wgid = (int)L; { const int q = nwg / NXCD, r = nwg % NXCD, xcd = wgid % NXCD, off = wgid / NXCD; wgid = (xcd < r ? xcd * (q + 1) : r * (q + 1) + (xcd - r) * q) + off; }
        const int nig = WGM * nN, gid = wgid / nig, fm = gid * WGM, gsz = (nM - fm) < WGM ? (nM - fm) : WGM;
        u.pm = fm + ((wgid % nig) % gsz); u.pn = (wgid % nig) / gsz; return true;
    }
    __device__ __forceinline__ void a_ready(const Unit&) const {}
    __device__ __forceinline__ void done(const Unit&) const {}
};

__device__ __forceinline__ unsigned cvt_pk_bf16(float lo, float hi) { unsigned r; asm volatile("v_cvt_pk_bf16_f32 %0, %1, %2" : "=v"(r) : "v"(lo), "v"(hi)); return r; }
typedef float f32x2 __attribute__((ext_vector_type(2)));
__device__ __forceinline__ void st8(bf16_t* p, f32x4 v0, f32x4 v1) {
    u32x4 w; w.x = cvt_pk_bf16(v0[0], v0[1]); w.y = cvt_pk_bf16(v0[2], v0[3]); w.z = cvt_pk_bf16(v1[0], v1[1]); w.w = cvt_pk_bf16(v1[2], v1[3]);
    *(u32x4*)p = w;
}
__device__ __forceinline__ void ld8(const bf16_t* p, f32x4& v0, f32x4& v1) {
    const u32x4 w = *(const u32x4*)p;
    v0[0] = __uint_as_float(w.x << 16); v0[1] = __uint_as_float(w.x & 0xffff0000u); v0[2] = __uint_as_float(w.y << 16); v0[3] = __uint_as_float(w.y & 0xffff0000u);
    v1[0] = __uint_as_float(w.z << 16); v1[1] = __uint_as_float(w.z & 0xffff0000u); v1[2] = __uint_as_float(w.w << 16); v1[3] = __uint_as_float(w.w & 0xffff0000u);
}
__device__ __forceinline__ float sigm(float x) { return __builtin_amdgcn_rcpf(1.f + __builtin_amdgcn_exp2f(x * -1.4426950408889634f)); }
template <int MODE> struct EpiB {
    static constexpr bool PERM = true, AFTER_DRAIN = false; static constexpr int MID_T = -1;
    unsigned char* ws; bf16_t* O; int ldc; const bf16_t* G; const bf16_t* T;
    __device__ __forceinline__ void operator()(const f32x4 (&acc)[2][2][4][2], const Unit& u, int wr, int wc, int fr, int fq) const {
        const int row0 = u.pm * BM + wr * 64 + fr; int colt = u.pn * BM; bf16_t* base = O; int ld = ldc; int tm = 0; float sc = 1.f;
        if (MODE == 0) {
            const int pn = u.pn; size_t off; int first;
            if (pn < 2)       { off = OFF_QR;  ld = 512;  first = 0;  tm = 0; }
            else if (pn < 4)  { off = OFF_KR;  ld = 512;  first = 2;  tm = 1; sc = 0.08838834764831845f; }
            else if (pn < 8)  { off = OFF_VR;  ld = 1024; first = 4;  tm = 0; }
            else if (pn < 12) { off = OFF_GR;  ld = 1024; first = 8;  tm = 2; }
            else if (pn < 14) { off = OFF_QS;  ld = 512;  first = 12; tm = 1; sc = 0.125f; }
            else if (pn < 15) { off = OFF_KVS; ld = 256;  first = 14; tm = 0; }
            else if (pn < 19) { off = OFF_GTR; ld = 1024; first = 15; tm = 3; }
            else              { off = OFF_GTS; ld = 1024; first = 19; tm = 3; }
            base = (bf16_t*)(ws + off); colt = (pn - first) * BM;
        }
        const int col0 = colt + wc * 32 + 8 * fq;
#pragma unroll
        for (int ai = 0; ai < 2; ++ai)
#pragma unroll
            for (int m = 0; m < 4; ++m) { const size_t ro = (size_t)(row0 + ai * HALF + m * 16) * ld + col0;
#pragma unroll
                for (int bj = 0; bj < 2; ++bj) { f32x4 v0 = acc[ai][bj][m][0], v1 = acc[ai][bj][m][1];
                    if (MODE == 0) {
                        if (tm == 0) { float one = 1.0f; asm volatile("" : "+v"(one)); v0 = v0 * one; v1 = v1 * one; }
                        else if (tm == 1) { v0 = v0 * sc; v1 = v1 * sc; }
                        else if (tm == 2) {
#pragma unroll
                            for (int q = 0; q < 4; ++q) { v0[q] = v0[q] * sigm(v0[q]); v1[q] = v1[q] * sigm(v1[q]); } }
                        else if (tm == 3) {
#pragma unroll
                            for (int q = 0; q < 4; ++q) { v0[q] = sigm(v0[q]); v1[q] = sigm(v1[q]); } }
                    } else if (MODE == 1) { f32x4 g0, g1; ld8(G + ro + bj * HALF, g0, g1); v0 = v0 * g0; v1 = v1 * g1; }
                    else if (MODE == 2) { f32x4 g0, g1, t0, t1; ld8(G + ro + bj * HALF, g0, g1); ld8(T + ro + bj * HALF, t0, t1); v0 = v0 * g0 + t0; v1 = v1 * g1 + t1; }
                    else if (MODE == 3) {
#pragma unroll
                        for (int q = 0; q < 4; ++q) { const float a = fmaxf(v0[q], 0.f), b = fmaxf(v1[q], 0.f); v0[q] = a * a; v1[q] = b * b; } }
                    st8(base + ro + bj * HALF, v0, v1); } }
    }
};
struct EpiF32 {
    static constexpr bool PERM = false, AFTER_DRAIN = false; static constexpr int MID_T = -1;
    float* O; int ldc;
    __device__ __forceinline__ void operator()(const f32x4 (&acc)[2][2][4][2], const Unit& u, int wr, int wc, int fr, int fq) const {
        const int row0 = u.pm * BM + wr * 64 + fr, col0 = u.pn * BM + wc * 32 + 4 * fq;
#pragma unroll
        for (int ai = 0; ai < 2; ++ai)
#pragma unroll
            for (int m = 0; m < 4; ++m) { float* rp = O + (size_t)(row0 + ai * HALF + m * 16) * ldc + col0;
#pragma unroll
                for (int bj = 0; bj < 2; ++bj)
#pragma unroll
                    for (int n = 0; n < 2; ++n) *(f32x4*)(rp + bj * HALF + n * 16) = acc[ai][bj][m][n]; }
    }
};

struct EpiMerged {
    static constexpr bool PERM = true, AFTER_DRAIN = false; static constexpr int MID_T = 16;
    bf16_t* O; const bf16_t* GR_; const bf16_t* GS_;
    __device__ __forceinline__ void mid(f32x4 (&acc)[2][2][4][2], const Unit& u, int wr, int wc, int fr_, int fq_) const {
        int fr = fr_, fq = fq_; asm volatile("" : "+v"(fr), "+v"(fq));
        const int row0 = u.pm * BM + wr * 64 + fr, col0 = u.pn * BM + wc * 32 + 8 * fq;
#pragma unroll
        for (int ai = 0; ai < 2; ++ai)
#pragma unroll
            for (int m = 0; m < 4; ++m) { const size_t ro = (size_t)(row0 + ai * HALF + m * 16) * 1024 + col0;
#pragma unroll
                for (int bj = 0; bj < 2; ++bj) { f32x4 r0, r1, s0, s1; ld8(GR_ + ro + bj * HALF, r0, r1); ld8(GS_ + ro + bj * HALF, s0, s1);
#pragma unroll
                    for (int q = 0; q < 4; ++q) { acc[ai][bj][m][0][q] *= r0[q] * __builtin_amdgcn_rcpf(fmaxf(s0[q], 1e-30f)); acc[ai][bj][m][1][q] *= r1[q] * __builtin_amdgcn_rcpf(fmaxf(s1[q], 1e-30f)); } }
                __builtin_amdgcn_sched_barrier(0); }
    }
    __device__ __forceinline__ void operator()(const f32x4 (&acc)[2][2][4][2], const Unit& u, int wr, int wc, int fr, int fq) const {
        const int row0 = u.pm * BM + wr * 64 + fr, col0 = u.pn * BM + wc * 32 + 8 * fq;
#pragma unroll
        for (int ai = 0; ai < 2; ++ai)
#pragma unroll
            for (int m = 0; m < 4; ++m) { const size_t ro = (size_t)(row0 + ai * HALF + m * 16) * 1024 + col0;
#pragma unroll
                for (int bj = 0; bj < 2; ++bj) { f32x4 s0, s1; ld8(GS_ + ro + bj * HALF, s0, s1); st8(O + ro + bj * HALF, acc[ai][bj][m][0] * s0, acc[ai][bj][m][1] * s1); } }
    }
};
struct OneUnit {
    StaticOrder base; int pass;
    __device__ bool next(int i, Unit& u) const { if (i != 0) return false; return base.next(pass, u); }
    __device__ __forceinline__ void a_ready(const Unit&) const {}
    __device__ __forceinline__ void done(const Unit&) const {}
};
struct RowSq {
    float* slots;
    unsigned* cnt;
    float eps;
    __device__ __forceinline__ void run(const f32x4 (&v)[2][2][4][2], const Unit& u, int wr, int wc, int fr, int fq, PG8_LAS unsigned char* lds, int wid, int lane) const {
        PG8_LAS float* P = (PG8_LAS float*)lds;
        PG8_LAS float* S = (PG8_LAS float*)(lds + 8192);
#pragma unroll
        for (int ai = 0; ai < 2; ++ai)
#pragma unroll
            for (int m = 0; m < 4; ++m) {
                float s = 0.f;
#pragma unroll
                for (int bj = 0; bj < 2; ++bj)
#pragma unroll
                    for (int n = 0; n < 2; ++n) { const f32x4 x = v[ai][bj][m][n]; s += (x[0] * x[0] + x[1] * x[1]) + (x[2] * x[2] + x[3] * x[3]); }
                s += __shfl_xor(s, 16); s += __shfl_xor(s, 32);
                if (fq == 0) P[(ai * HALF + wr * 64 + m * 16 + fr) * 4 + wc] = s;
            }
        asm volatile("s_waitcnt lgkmcnt(0)" ::: "memory"); __builtin_amdgcn_s_barrier(); asm volatile("" ::: "memory");
        const int row = wid * 32 + (lane & 31);
        if (lane < 32) {
            const float tot = (P[row * 4 + 0] + P[row * 4 + 1]) + (P[row * 4 + 2] + P[row * 4 + 3]);
            __hip_atomic_store(slots + (size_t)(u.pm * BM + row) * 4 + u.pn, tot, __ATOMIC_RELAXED, __HIP_MEMORY_SCOPE_AGENT);
        }
        asm volatile("s_waitcnt vmcnt(0)" ::: "memory");
        if (lane == 0) __hip_atomic_fetch_add(cnt + 64 * u.pm, 1u, __ATOMIC_RELAXED, __HIP_MEMORY_SCOPE_AGENT);
        if (wid == 0) {
            unsigned spins = 0;
            while ((unsigned)__builtin_amdgcn_readfirstlane(__hip_atomic_load(cnt + 64 * u.pm, __ATOMIC_RELAXED, __HIP_MEMORY_SCOPE_AGENT)) < 32u) {
                __builtin_amdgcn_s_sleep(2); if (++spins > (1u << 24)) break; }
            __builtin_amdgcn_fence(__ATOMIC_ACQUIRE, "agent");
        }
        asm volatile("s_waitcnt vmcnt(0) lgkmcnt(0)" ::: "memory"); __builtin_amdgcn_s_barrier(); asm volatile("" ::: "memory");
        if (lane < 32) {
            const float* sl = slots + (size_t)(u.pm * BM + row) * 4; float t = 0.f;
#pragma unroll
            for (int k = 0; k < 4; ++k) t += __hip_atomic_load(sl + k, __ATOMIC_RELAXED, __HIP_MEMORY_SCOPE_AGENT);
            S[row] = rsqrtf(t * (1.0f / 1024.0f) + eps);
        }
        asm volatile("s_waitcnt lgkmcnt(0)" ::: "memory"); __builtin_amdgcn_s_barrier(); asm volatile("" ::: "memory");
    }
    __device__ __forceinline__ void publish(const f32x4 (&v)[2][2][4][2], const Unit& u, int wr, int wc, int fr, int fq, PG8_LAS unsigned char* lds, int wid, int lane) const {
        PG8_LAS float* P = (PG8_LAS float*)lds;
#pragma unroll
        for (int ai = 0; ai < 2; ++ai)
#pragma unroll
            for (int m = 0; m < 4; ++m) {
                float s = 0.f;
#pragma unroll
                for (int bj = 0; bj < 2; ++bj)
#pragma unroll
                    for (int n = 0; n < 2; ++n) { const f32x4 x = v[ai][bj][m][n]; s += (x[0] * x[0] + x[1] * x[1]) + (x[2] * x[2] + x[3] * x[3]); }
                s += __shfl_xor(s, 16); s += __shfl_xor(s, 32);
                if (fq == 0) P[(ai * HALF + wr * 64 + m * 16 + fr) * 4 + wc] = s;
            }
        asm volatile("s_waitcnt lgkmcnt(0)" ::: "memory"); __builtin_amdgcn_s_barrier(); asm volatile("" ::: "memory");
        const int row = wid * 32 + (lane & 31);
        if (lane < 32) slots[(size_t)(u.pm * BM + row) * 4 + u.pn] = (P[row * 4 + 0] + P[row * 4 + 1]) + (P[row * 4 + 2] + P[row * 4 + 3]);
    }
};
struct EpiRmsResRms {
    static constexpr bool PERM = true, AFTER_DRAIN = true; static constexpr int MID_T = -1;
    const float* base; bf16_t* out; const float* g1; RowSq st1, st2;
    __device__ __forceinline__ void fused(f32x4 (&acc)[2][2][4][2], const Unit& u, int wr, int wc, int fr, int fq, PG8_LAS unsigned char* lds, int wid, int lane) const {
        typedef unsigned u32x2v __attribute__((ext_vector_type(2)));
        const PG8_LAS float* S = (const PG8_LAS float*)(lds + 8192);
        const int col0 = u.pn * BM + wc * 32 + 8 * fq;
        st1.run(acc, u, wr, wc, fr, fq, lds, wid, lane);
#pragma unroll
        for (int ai = 0; ai < 2; ++ai)
#pragma unroll
            for (int m = 0; m < 4; ++m) { const int r = ai * HALF + wr * 64 + m * 16 + fr; const float sr = S[r]; const size_t off = (size_t)(u.pm * BM + r) * 1024 + col0;
#pragma unroll
                for (int bj = 0; bj < 2; ++bj)
#pragma unroll
                    for (int n = 0; n < 2; ++n) { const f32x4 bs = *(const f32x4*)(base + off + bj * HALF + n * 4); const f32x4 gv = *(const f32x4*)(g1 + col0 + bj * HALF + n * 4);
                        acc[ai][bj][m][n] = bs + acc[ai][bj][m][n] * sr * gv; }
                asm volatile("" : "+v"(acc[ai][0][m][0]), "+v"(acc[ai][0][m][1]), "+v"(acc[ai][1][m][0]), "+v"(acc[ai][1][m][1]));
                if (m & 1) asm volatile("" ::: "memory"); }
        st2.publish(acc, u, wr, wc, fr, fq, lds, wid, lane);
#pragma unroll
        for (int ai = 0; ai < 2; ++ai)
#pragma unroll
            for (int m = 0; m < 4; ++m) { const int r = ai * HALF + wr * 64 + m * 16 + fr; const size_t off = (size_t)(u.pm * BM + r) * 1024 + col0;
#pragma unroll
                for (int bj = 0; bj < 2; ++bj) { const f32x4 xa = acc[ai][bj][m][0], xb = acc[ai][bj][m][1];
                    u32x4 w1; w1.x = cvt_pk_bf16(xa[0], xa[1]); w1.y = cvt_pk_bf16(xa[2], xa[3]); w1.z = cvt_pk_bf16(xb[0], xb[1]); w1.w = cvt_pk_bf16(xb[2], xb[3]); *(u32x4*)(out + off + bj * HALF) = w1; }
                asm volatile("" ::: "memory"); }
    }
};
struct EpiRmsRes {
    static constexpr bool PERM = true, AFTER_DRAIN = true; static constexpr int MID_T = -1;
    const bf16_t* base; float* out; const float* g1; RowSq st;
    __device__ __forceinline__ void fused(f32x4 (&acc)[2][2][4][2], const Unit& u, int wr, int wc, int fr, int fq, PG8_LAS unsigned char* lds, int wid, int lane) const {
        const PG8_LAS float* S = (const PG8_LAS float*)(lds + 8192);
        const int col0 = u.pn * BM + wc * 32 + 8 * fq;
        st.run(acc, u, wr, wc, fr, fq, lds, wid, lane);
#pragma unroll
        for (int ai = 0; ai < 2; ++ai)
#pragma unroll
            for (int m = 0; m < 4; ++m) { const int r = ai * HALF + wr * 64 + m * 16 + fr; const float sr = S[r]; const size_t off = (size_t)(u.pm * BM + r) * 1024 + col0;
#pragma unroll
                for (int bj = 0; bj < 2; ++bj) { f32x4 ba, bb; ld8(base + off + bj * HALF, ba, bb);
                    const f32x4 ga = *(const f32x4*)(g1 + col0 + bj * HALF), gb = *(const f32x4*)(g1 + col0 + bj * HALF + 4);
                    *(f32x4*)(out + off + bj * HALF) = ba + acc[ai][bj][m][0] * sr * ga; *(f32x4*)(out + off + bj * HALF + 4) = bb + acc[ai][bj][m][1] * sr * gb; }
                if (m & 1) asm volatile("" ::: "memory"); }
    }
};

struct EpiUp {
    static constexpr bool PERM = true, AFTER_DRAIN = false; static constexpr int MID_T = -1;
    bf16_t* O; const float* part;
    __device__ __forceinline__ void operator()(const f32x4 (&acc)[2][2][4][2], const Unit& u, int wr, int wc, int fr, int fq) const {
        const int row0 = u.pm * BM + wr * 64 + fr, col0 = u.pn * BM + wc * 32 + 8 * fq;
#pragma unroll
        for (int ai = 0; ai < 2; ++ai)
#pragma unroll
            for (int m = 0; m < 4; ++m) { const int row = row0 + ai * HALF + m * 16; const f32x4 pp = *(const f32x4*)(part + (size_t)row * 4);
                const float sc = __builtin_amdgcn_rcpf(((pp[0] + pp[1]) + (pp[2] + pp[3])) * (1.0f / 1024.0f) + 1e-6f); const size_t ro = (size_t)row * FF + col0;
#pragma unroll
                for (int bj = 0; bj < 2; ++bj) { f32x4 v0 = acc[ai][bj][m][0], v1 = acc[ai][bj][m][1];
#pragma unroll
                    for (int q = 0; q < 4; ++q) { const float a = fmaxf(v0[q], 0.f), b = fmaxf(v1[q], 0.f); v0[q] = a * a * sc; v1[q] = b * b * sc; }
                    st8(O + ro + bj * HALF, v0, v1); } }
    }
};
template <class Epi, class Sched, bool ALIGN_EPI = false, bool SP2 = false>
__device__ __forceinline__ void gemm_phase(PG8_LAS unsigned char* lds, const Gemm g, const Sched& S, const Epi& E) {
    const int tid = threadIdx.x, wid = __builtin_amdgcn_readfirstlane(tid >> 6), lane = tid & 63, wr = wid >> 2, wc = wid & 3, fr = lane & 15, fq = lane >> 4;
    const int K = g.K, nt = K / BK;
    unsigned voffA[2], voffB[2];
#pragma unroll
    for (int i = 0; i < 2; ++i) { int R, C; stage_rc(tid * 16 + i * 8192, R, C); const int Rb = Epi::PERM ? ((R & ~31) + perm32(R & 31)) : R;
        voffA[i] = (unsigned)(R * K + C) * 2u; voffB[i] = (unsigned)(Rb * K + C) * 2u; }
    const size_t kstep = (size_t)(BK * 2);
    const size_t hstep = (size_t)HALF * K * 2;
    const size_t tstep = 2 * hstep;
    const unsigned ldsw = (unsigned)wid * 1024u;
    const int aoff = lds_byte(wr * 64 + fr, fq * 8), boff = lds_byte(wc * 32 + fr, fq * 8);
#define PG8_SA(b, h) (((b) * 2 + (h)) * HTB)
#define PG8_SB(b, h) ((4 + (b) * 2 + (h)) * HTB)
#define PG8_STAGE(bufoff, gbase, voff) do { _Pragma("unroll") for (int _i = 0; _i < 2; ++_i) \
        __builtin_amdgcn_global_load_lds((const unsigned*)((const char*)(gbase) + (voff)[_i]), (PG8_LAS unsigned*)(lds + (bufoff) + ldsw + _i * 8192), 16, 0, 0); } while (0)
#define PG8_LDA(dst, b, h) do { _Pragma("unroll") for (int m = 0; m < 4; ++m) _Pragma("unroll") for (int k = 0; k < 2; ++k) dst[m][k] = *(const PG8_LAS bf16x8*)(lds + PG8_SA(b, h) + aoff + m * 2048 + k * 1024); } while (0)
#define PG8_LDB(dst, b, h) do { _Pragma("unroll") for (int n = 0; n < 2; ++n) _Pragma("unroll") for (int k = 0; k < 2; ++k) dst[n][k] = *(const PG8_LAS bf16x8*)(lds + PG8_SB(b, h) + boff + n * 2048 + k * 1024); } while (0)
#define PG8_MMA(ai, bj, At, Bt) do { __builtin_amdgcn_s_setprio(1); _Pragma("unroll") for (int m = 0; m < 4; ++m) _Pragma("unroll") for (int n = 0; n < 2; ++n) _Pragma("unroll") for (int k = 0; k < 2; ++k) \
        acc[ai][bj][m][n] = __builtin_amdgcn_mfma_f32_16x16x32_bf16(Bt[n][k], At[m][k], acc[ai][bj][m][n], 0, 0, 0); __builtin_amdgcn_s_setprio(0); } while (0)
#define PG8_WAIT_V(n) asm volatile("s_waitcnt vmcnt(" #n ")" ::: "memory")
#define PG8_WAIT_L(n) asm volatile("s_waitcnt lgkmcnt(" #n ")" ::: "memory")
#define PG8_BAR __builtin_amdgcn_s_barrier()
#define PG8_SCHED __builtin_amdgcn_sched_barrier(0)
    Unit cur, nxt; int ui = 0;
    if (!S.next(0, cur)) return;
    f32x4 acc[2][2][4][2];
#pragma unroll
    for (int a = 0; a < 2; ++a)
#pragma unroll
        for (int b = 0; b < 2; ++b)
#pragma unroll
            for (int m = 0; m < 4; ++m)
#pragma unroll
                for (int n = 0; n < 2; ++n) acc[a][b][m][n] = (f32x4){0.f, 0.f, 0.f, 0.f};
    bf16x8 At[4][2], B0[2][2], B1[2][2];
    const char* cA = (const char*)g.A + (size_t)cur.pm * tstep; const char* cB = (const char*)g.Bt + (size_t)cur.pn * tstep;
    S.a_ready(cur);
    if constexpr (SP2) {
        PG8_STAGE(PG8_SB(0, 0), cB, voffB); PG8_STAGE(PG8_SB(0, 1), cB + hstep, voffB); PG8_STAGE(PG8_SA(0, 0), cA, voffA); PG8_STAGE(PG8_SA(0, 1), cA + hstep, voffA);
        if (wr == 1) PG8_BAR;
        PG8_WAIT_V(2); PG8_BAR;
        PG8_STAGE(PG8_SB(1, 0), cB + kstep, voffB); PG8_STAGE(PG8_SA(1, 0), cA + kstep, voffA); PG8_STAGE(PG8_SB(1, 1), cB + hstep + kstep, voffB);
        PG8_WAIT_V(6); PG8_BAR;
    } else {
        PG8_STAGE(PG8_SB(0, 0), cB, voffB); PG8_STAGE(PG8_SA(0, 0), cA, voffA); PG8_STAGE(PG8_SB(0, 1), cB + hstep, voffB); PG8_STAGE(PG8_SA(0, 1), cA + hstep, voffA);
        if (wr == 1) PG8_BAR;
        PG8_WAIT_V(4); PG8_BAR;
        PG8_STAGE(PG8_SB(1, 0), cB + kstep, voffB); PG8_STAGE(PG8_SA(1, 0), cA + kstep, voffA); PG8_STAGE(PG8_SB(1, 1), cB + hstep + kstep, voffB);
        PG8_WAIT_V(6); PG8_BAR;
    }
    for (;;) {
        const bool has_next = S.next(ui + 1, nxt);
        const char* nA = has_next ? (const char*)g.A + (size_t)nxt.pm * tstep : cA; const char* nB = has_next ? (const char*)g.Bt + (size_t)nxt.pn * tstep : cB;
        for (int t = 0; t < nt; t += 2) {
            if constexpr (Epi::MID_T >= 0) { if (t == Epi::MID_T) E.mid(acc, cur, wr, wc, fr, fq); }
            const bool last = (t == nt - 2);
            const char* a1 = cA + (size_t)(t + 1) * kstep;
            const char* a2 = last ? nA : cA + (size_t)(t + 2) * kstep; const char* b2 = last ? nB : cB + (size_t)(t + 2) * kstep;
            const char* a3 = a2 + kstep; const char* b3 = b2 + kstep;
            if (last && has_next) S.a_ready(nxt);
            if constexpr (SP2) {
            PG8_LDB(B0, 0, 0); PG8_LDB(B1, 0, 1); PG8_SCHED; PG8_LDA(At, 0, 0); PG8_STAGE(PG8_SA(1, 1), a1 + hstep, voffA);
            PG8_WAIT_V(8); PG8_WAIT_L(0); PG8_BAR; PG8_MMA(0, 0, At, B0); PG8_MMA(0, 1, At, B1); PG8_BAR; PG8_SCHED;
            PG8_LDA(At, 0, 1); PG8_STAGE(PG8_SB(0, 0), b2, voffB); PG8_STAGE(PG8_SB(0, 1), b2 + hstep, voffB); PG8_STAGE(PG8_SA(0, 0), a2, voffA);
            PG8_WAIT_V(8); PG8_WAIT_L(0); PG8_BAR; PG8_MMA(1, 0, At, B0); PG8_MMA(1, 1, At, B1); PG8_BAR; PG8_SCHED;
            PG8_LDB(B0, 1, 0); PG8_LDB(B1, 1, 1); PG8_SCHED; PG8_LDA(At, 1, 0); PG8_STAGE(PG8_SA(0, 1), a2 + hstep, voffA);
            PG8_WAIT_V(8); PG8_WAIT_L(0); PG8_BAR; PG8_MMA(0, 0, At, B0); PG8_MMA(0, 1, At, B1); PG8_BAR; PG8_SCHED;
            PG8_LDA(At, 1, 1); PG8_STAGE(PG8_SB(1, 0), b3, voffB); PG8_STAGE(PG8_SB(1, 1), b3 + hstep, voffB); PG8_STAGE(PG8_SA(1, 0), a3, voffA);
            PG8_WAIT_V(8); PG8_WAIT_L(0); PG8_BAR; PG8_MMA(1, 0, At, B0); PG8_MMA(1, 1, At, B1); PG8_BAR; PG8_SCHED;
            } else {
            PG8_LDB(B0, 0, 0); PG8_SCHED; PG8_LDA(At, 0, 0); PG8_STAGE(PG8_SA(1, 1), a1 + hstep, voffA);
            PG8_WAIT_L(8); PG8_BAR; PG8_WAIT_L(0); PG8_MMA(0, 0, At, B0); PG8_BAR; PG8_SCHED;
            PG8_LDB(B1, 0, 1); PG8_STAGE(PG8_SB(0, 0), b2, voffB);
            PG8_BAR; PG8_WAIT_L(0); PG8_MMA(0, 1, At, B1); PG8_BAR;
            PG8_LDA(At, 0, 1); PG8_STAGE(PG8_SA(0, 0), a2, voffA);
            PG8_BAR; PG8_WAIT_L(0); PG8_MMA(1, 0, At, B0); PG8_BAR; PG8_SCHED;
            PG8_STAGE(PG8_SB(0, 1), b2 + hstep, voffB);
            PG8_WAIT_V(6); PG8_BAR; PG8_MMA(1, 1, At, B1); PG8_BAR;
            PG8_LDB(B0, 1, 0); PG8_SCHED; PG8_LDA(At, 1, 0); PG8_STAGE(PG8_SA(0, 1), a2 + hstep, voffA);
            PG8_WAIT_L(8); PG8_BAR; PG8_WAIT_L(0); PG8_MMA(0, 0, At, B0); PG8_BAR; PG8_SCHED;
            PG8_LDB(B1, 1, 1); PG8_STAGE(PG8_SB(1, 0), b3, voffB);
            PG8_BAR; PG8_WAIT_L(0); PG8_MMA(0, 1, At, B1); PG8_BAR;
            PG8_LDA(At, 1, 1); PG8_STAGE(PG8_SA(1, 0), a3, voffA);
            PG8_BAR; PG8_WAIT_L(0); PG8_MMA(1, 0, At, B0); PG8_BAR; PG8_SCHED;
            PG8_STAGE(PG8_SB(1, 1), b3 + hstep, voffB);
            PG8_WAIT_V(6); PG8_BAR; PG8_MMA(1, 1, At, B1); PG8_BAR;
            }
        }
        if constexpr (ALIGN_EPI) { if (wr == 0) PG8_BAR; }
        if constexpr (!Epi::AFTER_DRAIN) { E(acc, cur, wr, wc, fr, fq); S.done(cur); }
        if (!has_next) break;
#pragma unroll
        for (int a = 0; a < 2; ++a)
#pragma unroll
            for (int b = 0; b < 2; ++b)
#pragma unroll
                for (int m = 0; m < 4; ++m)
#pragma unroll
                    for (int n = 0; n < 2; ++n) acc[a][b][m][n] = (f32x4){0.f, 0.f, 0.f, 0.f};
        cur = nxt; cA = nA; cB = nB; ++ui;
        if constexpr (ALIGN_EPI) { if (wr == 1) PG8_BAR; }
    }
    PG8_WAIT_V(0);
    if constexpr (!ALIGN_EPI) { if (wr == 0) PG8_BAR; }
    PG8_BAR;
    if constexpr (Epi::AFTER_DRAIN) { E.fused(acc, cur, wr, wc, fr, fq, lds, wid, lane); S.done(cur); }
#undef PG8_SA
#undef PG8_SB
#undef PG8_STAGE
#undef PG8_LDA
#undef PG8_LDB
#undef PG8_MMA
#undef PG8_WAIT_V
#undef PG8_WAIT_L
#undef PG8_BAR
#undef PG8_SCHED
}
}
#ifndef USE_NEW_KV
#define USE_NEW_KV 1
#endif
#ifndef USE_NEW_SWA
#define USE_NEW_SWA 1
#endif
#ifndef USE_NEW_RET
#define USE_NEW_RET 1
#endif
#define LAS __attribute__((address_space(3)))
typedef unsigned short bf16;
typedef float f32x4 __attribute__((ext_vector_type(4)));
typedef unsigned v4u __attribute__((ext_vector_type(4)));
typedef unsigned v2u __attribute__((ext_vector_type(2)));
constexpr int NWAVES = 8, NTHR = 512;
constexpr int LDS_BYTES = 147456;
__device__ __forceinline__ unsigned f2bf(float f) { unsigned u = __builtin_bit_cast(unsigned, f); return (u + 0x7fffu + ((u >> 16) & 1u)) >> 16; }
__device__ __forceinline__ unsigned pk2(float lo, float hi) { return f2bf(lo) | (f2bf(hi) << 16); }
__device__ __forceinline__ float bf2f(bf16 b) { return __uint_as_float((unsigned)b << 16); }
__device__ __forceinline__ float wave_sum(float v) {
#pragma unroll
    for (int o = 1; o < 64; o <<= 1) v += __shfl_xor(v, o);
    return v;
}
#define LDS_WAIT() asm volatile("s_waitcnt lgkmcnt(0)" ::: "memory")

#define XB_TMO      128
#define XB_XCNT(j)  (256  + 64 * (j))
#define XB_XSUB(j)  (1280 + 64 * (j))
#define XB_XGEN(j)  (2304 + 64 * (j))
#define XB_TOP      3328
#define XB_TOPGEN   3392
#define XCD_BAR_WORDS 3456
#define XB_SPIN_CAP (1u << 18)

__device__ __forceinline__ unsigned xb_ld(unsigned* p)              { return __hip_atomic_load(p, __ATOMIC_RELAXED, __HIP_MEMORY_SCOPE_AGENT); }
__device__ __forceinline__ unsigned xb_add(unsigned* p, unsigned v) { return __hip_atomic_fetch_add(p, v, __ATOMIC_RELAXED, __HIP_MEMORY_SCOPE_AGENT); }
__device__ __forceinline__ unsigned xb_xcc_id() { return (unsigned)__builtin_amdgcn_s_getreg((3 << 11) | 20) & 0xFu; }
#define XB_SPIN(cond, bar) do { unsigned _sp = 0; while (cond) { __builtin_amdgcn_s_sleep(1); \
    if ((++_sp & 255u) == 0u) { if (xb_ld(&(bar)[XB_TMO])) break; if (_sp > XB_SPIN_CAP) { atomicAdd(&(bar)[XB_TMO], 1u); break; } } } } while (0)

struct XcdBarrier {
    unsigned* bar; unsigned x;
    volatile LAS unsigned* st;
};

__device__ __forceinline__ XcdBarrier xcd_barrier_post(unsigned* bar, volatile LAS unsigned* st) {
    XcdBarrier b; b.bar = bar; b.x = xb_xcc_id(); b.st = st;
    if (threadIdx.x == 0) (void)xb_add(&bar[XB_XCNT(b.x)], 1u);
    return b;
}
__device__ __forceinline__ void xcd_barrier_complete(unsigned* bar, unsigned x, unsigned& nloc, unsigned& nx) {
    const unsigned G = gridDim.x * gridDim.y * gridDim.z;
    unsigned sum, cnt, mine, sp = 0u;
    for (;;) {
        sum = 0u; cnt = 0u; mine = 0u;
#pragma unroll
        for (unsigned j = 0; j < 16; ++j) { const unsigned c = xb_ld(&bar[XB_XCNT(j)]); sum += c; cnt += (c > 0u) ? 1u : 0u; mine = (j == x) ? c : mine; }
        if (sum == G) break;
        __builtin_amdgcn_s_sleep(1);
        if ((++sp & 255u) == 0u) { if (xb_ld(&bar[XB_TMO])) break; if (sp > XB_SPIN_CAP) { atomicAdd(&bar[XB_TMO], 1u); break; } }
    }
    nloc = mine > 0u ? mine : 1u; nx = cnt > 0u ? cnt : 1u;
}

__device__ __forceinline__ void xcd_barrier(const XcdBarrier& b) {
    asm volatile("s_waitcnt vmcnt(0)" ::: "memory");
    __syncthreads();
    if (threadIdx.x == 0) {
        unsigned* bar = b.bar;
        __builtin_amdgcn_s_waitcnt(0);
        unsigned nloc = b.st[0], nx = b.st[1];
        if (nloc == 0u) { xcd_barrier_complete(bar, b.x, nloc, nx); b.st[0] = nloc; b.st[1] = nx; }
        const unsigned old = xb_add(&bar[XB_XSUB(b.x)], 1u);
        const unsigned gen = old / nloc;
        if (old + 1u == (gen + 1u) * nloc) {
            __builtin_amdgcn_fence(__ATOMIC_RELEASE, "agent");
            asm volatile("s_waitcnt vmcnt(0)" ::: "memory");
            const unsigned og = xb_add(&bar[XB_TOP], 1u);
            const unsigned tg = og / nx;
            if (og + 1u == (tg + 1u) * nx) xb_add(&bar[XB_TOPGEN], 1u);
            else XB_SPIN(xb_ld(&bar[XB_TOPGEN]) == tg, bar);
            __builtin_amdgcn_fence(__ATOMIC_ACQUIRE, "agent");
            xb_add(&bar[XB_XGEN(b.x)], 1u);
            asm volatile("s_waitcnt vmcnt(0)" ::: "memory");
        } else {
            XB_SPIN(xb_ld(&bar[XB_XGEN(b.x)]) == gen, bar);
            __builtin_amdgcn_fence(__ATOMIC_ACQUIRE, "agent");
            asm volatile("s_waitcnt vmcnt(0)" ::: "memory");
        }
    }
    __syncthreads();
}

__device__ __forceinline__ void p0_transpose_item(const float* W, int K, int N, bf16* WT, LAS float* scr, int item, int lane, int ldk = 0, int koff = 0, const float* gk = nullptr) {
    if (ldk == 0) ldk = K;
    const int nblk = N / 32, kb = item / nblk, nb = item % nblk, k0 = 64 * kb, n0 = 32 * nb;
    float wv[32];
#pragma unroll
    for (int i = 0; i < 32; ++i) { const int kk = 2 * i + (lane >> 5); wv[i] = W[(size_t)(k0 + kk) * N + n0 + (lane & 31)]; }
#pragma unroll
    for (int i = 0; i < 32; ++i) { const int kk = 2 * i + (lane >> 5); scr[kk * 33 + (lane & 31)] = gk ? wv[i] * gk[k0 + kk] : wv[i]; }
    LDS_WAIT(); asm volatile("" ::: "memory");
    const int c = lane & 7;
#pragma unroll
    for (int j = 0; j < 4; ++j) { const int n = (lane >> 3) + 8 * j; const LAS float* s = scr + (8 * c) * 33 + n;
        v4u o; o.x = pk2(s[0 * 33], s[1 * 33]); o.y = pk2(s[2 * 33], s[3 * 33]); o.z = pk2(s[4 * 33], s[5 * 33]); o.w = pk2(s[6 * 33], s[7 * 33]);
        *(v4u*)(WT + (size_t)(n0 + n) * ldk + koff + k0 + 8 * c) = o; }
    LDS_WAIT(); asm volatile("" ::: "memory");
}

typedef short bf16x8 __attribute__((ext_vector_type(8)));
typedef short s16x4 __attribute__((ext_vector_type(4)));
typedef short v4i16_t __attribute__((ext_vector_type(4)));
__device__ __forceinline__ s16x4 trrd(const LAS unsigned char* p) { return __builtin_bit_cast(s16x4, __builtin_amdgcn_ds_read_tr16_b64_v4i16((LAS v4i16_t*)p)); }
__device__ __forceinline__ bf16x8 cat8(s16x4 a, s16x4 b) { return __builtin_shufflevector(a, b, 0, 1, 2, 3, 4, 5, 6, 7); }
__device__ __forceinline__ bf16x8 packf8(f32x4 a, f32x4 b) {
    v4u w; w.x = pg8::cvt_pk_bf16(a[0], a[1]); w.y = pg8::cvt_pk_bf16(a[2], a[3]); w.z = pg8::cvt_pk_bf16(b[0], b[1]); w.w = pg8::cvt_pk_bf16(b[2], b[3]);
    return __builtin_bit_cast(bf16x8, w);
}
__device__ __forceinline__ float vis1() { float one = 1.0f; asm volatile("" : "+v"(one)); return one; }
__device__ __forceinline__ v2u packf4(f32x4 a) { v2u w; w.x = pg8::cvt_pk_bf16(a[0], a[1]); w.y = pg8::cvt_pk_bf16(a[2], a[3]); return w; }
__device__ __forceinline__ f32x4 unpk4(v2u w) { f32x4 r; r[0] = __uint_as_float(w.x << 16); r[1] = __uint_as_float(w.x & 0xffff0000u); r[2] = __uint_as_float(w.y << 16); r[3] = __uint_as_float(w.y & 0xffff0000u); return r; }
#define MFMA16(a, b, c) __builtin_amdgcn_mfma_f32_16x16x32_bf16((a), (b), (c), 0, 0, 0)

__device__ __forceinline__ void kv_unit(LAS unsigned char* lds, const bf16* KR, const bf16* VR, bf16* ST, int unit, int tid, int lane, int wid) {
    constexpr int PBK = 288, PBV = 544;
    LAS unsigned char* Kimg = lds; LAS unsigned char* Vimg = lds + 128 * PBK;
    const int n = unit & 63, bh = unit >> 6, b = bh >> 2, h = bh & 3;
    const float lg2 = log2f(1.f - exp2f(-5.f - (float)h));
    const size_t t0 = (size_t)b * SEQ + n * 128;
#pragma unroll
    for (int it = 0; it < 4; ++it) { const int c = tid + it * NTHR, j = c >> 4, ch = c & 15;
        const v4u w = *(const v4u*)(KR + (t0 + j) * 512 + h * 128 + ch * 8); const float dec = exp2f((float)(127 - j) * lg2);
        const f32x4 a = unpk4((v2u){w.x, w.y}) * dec, bb = unpk4((v2u){w.z, w.w}) * dec;
        *(LAS bf16x8*)(Kimg + j * PBK + ch * 16) = packf8(a, bb); }
#pragma unroll
    for (int it = 0; it < 8; ++it) { const int c = tid + it * NTHR, j = c >> 5, ch = c & 31;
        *(LAS v4u*)(Vimg + j * PBV + ch * 16) = *(const v4u*)(VR + (t0 + j) * 1024 + h * 256 + ch * 8); }
    __syncthreads();
    const int c16 = lane & 15, g = lane >> 4, q = c16 >> 2, p = c16 & 3;
    f32x4 acc[8][2];
#pragma unroll
    for (int dt = 0; dt < 8; ++dt) { acc[dt][0] = (f32x4){0.f, 0.f, 0.f, 0.f}; acc[dt][1] = (f32x4){0.f, 0.f, 0.f, 0.f}; }
#pragma unroll
    for (int ks = 0; ks < 4; ++ks) {
        const LAS unsigned char* ka = Kimg + (32 * ks + 4 * g + q) * PBK + p * 8;
        const LAS unsigned char* va = Vimg + (32 * ks + 4 * g + q) * PBV + p * 8 + wid * 64;
        bf16x8 B[2];
#pragma unroll
        for (int et = 0; et < 2; ++et) B[et] = cat8(trrd(va + et * 32), trrd(va + 16 * PBV + et * 32));
#pragma unroll
        for (int dt = 0; dt < 8; ++dt) { const bf16x8 A = cat8(trrd(ka + dt * 32), trrd(ka + 16 * PBK + dt * 32));
            acc[dt][0] = MFMA16(A, B[0], acc[dt][0]); acc[dt][1] = MFMA16(A, B[1], acc[dt][1]); }
    }
#pragma unroll
    for (int dt = 0; dt < 8; ++dt)
#pragma unroll
        for (int et = 0; et < 2; ++et) *(v2u*)(ST + ((size_t)unit * 256 + 32 * wid + 16 * et + c16) * 128 + 16 * dt + 4 * g) = packf4(acc[dt][et] * vis1());
    __syncthreads();
}

__device__ __forceinline__ void swa_unit(LAS unsigned char* lds, const bf16* QS, const bf16* KVS, const float* sinks, bf16* SWA, int unit, int tid, int lane, int wid) {
    constexpr int PK = 144, PV = 160;
    LAS unsigned char* Kimg = lds; LAS unsigned char* Vimg = lds + 256 * PK;
    const int g2 = unit & 1, n = (unit >> 1) & 63, b = unit >> 7;
    const size_t t0 = (size_t)b * SEQ + n * 128;
#pragma unroll
    for (int it = 0; it < 4; ++it) { const int c = tid + it * NTHR, j = c >> 3, ch = c & 7;
        v4u wk = (v4u){0u, 0u, 0u, 0u}, wv = (v4u){0u, 0u, 0u, 0u};
        if (n > 0 || j >= 128) { const bf16* src = KVS + (t0 + j - 128) * 256 + g2 * 64 + ch * 8; wk = *(const v4u*)src; wv = *(const v4u*)(src + 128); }
        *(LAS v4u*)(Kimg + j * PK + ch * 16) = wk; *(LAS v4u*)(Vimg + j * PV + ch * 16) = wv; }
    __syncthreads();
    const int c16 = lane & 15, g = lane >> 4, q = c16 >> 2, p = c16 & 3;
    const int jt0 = 2 * (wid >> 1), i = 16 * wid + c16;
#pragma unroll 1
    for (int r = 0; r < 4; ++r) {
        const int hq = g2 * 4 + r;
        const float slope = exp2f(-(float)(hq + 1)), sink = sinks[hq];
        bf16x8 qf[2];
#pragma unroll
        for (int ks = 0; ks < 2; ++ks) qf[ks] = *(const bf16x8*)(QS + (t0 + i) * 512 + hq * 64 + 32 * ks + 8 * g);
        f32x4 s[10];
#pragma unroll
        for (int jt = 0; jt < 10; ++jt) { s[jt] = (f32x4){0.f, 0.f, 0.f, 0.f};
#pragma unroll
            for (int ks = 0; ks < 2; ++ks) { const bf16x8 A = *(const LAS bf16x8*)(Kimg + (16 * (jt0 + jt) + c16) * PK + (32 * ks + 8 * g) * 2); s[jt] = MFMA16(A, qf[ks], s[jt]); } }
        float mx = sink;
#pragma unroll
        for (int jt = 0; jt < 10; ++jt)
#pragma unroll
            for (int rr = 0; rr < 4; ++rr) { const int j = 16 * (jt0 + jt) + 4 * g + rr, dist = i + 128 - j;
                const bool valid = dist >= 0 && dist < 128 && (n > 0 || j >= 128);
                const float v = valid ? s[jt][rr] - slope * (float)dist : -INFINITY; s[jt][rr] = v; mx = fmaxf(mx, v); }
        mx = fmaxf(mx, __shfl_xor(mx, 16)); mx = fmaxf(mx, __shfl_xor(mx, 32));
        float l = 0.f;
#pragma unroll
        for (int jt = 0; jt < 10; ++jt)
#pragma unroll
            for (int rr = 0; rr < 4; ++rr) { const float v = s[jt][rr]; const float pe = (v == -INFINITY) ? 0.f : __expf(v - mx); s[jt][rr] = pe; l += pe; }
        l += __shfl_xor(l, 16); l += __shfl_xor(l, 32); l += __expf(sink - mx);
        const float inv = 1.f / l;
        bf16x8 pf[5];
#pragma unroll
        for (int kp = 0; kp < 5; ++kp) pf[kp] = packf8(s[2 * kp] * inv, s[2 * kp + 1] * inv);
        f32x4 o[4];
#pragma unroll
        for (int dt = 0; dt < 4; ++dt) o[dt] = (f32x4){0.f, 0.f, 0.f, 0.f};
#pragma unroll
        for (int kp = 0; kp < 5; ++kp) { const LAS unsigned char* va = Vimg + (16 * (jt0 + 2 * kp) + 4 * g + q) * PV + p * 8;
#pragma unroll
            for (int dt = 0; dt < 4; ++dt) o[dt] = MFMA16(cat8(trrd(va + dt * 32), trrd(va + 16 * PV + dt * 32)), pf[kp], o[dt]); }
#pragma unroll
        for (int dt = 0; dt < 4; ++dt) *(v2u*)(SWA + (t0 + i) * 1536 + hq * 64 + 16 * dt + 4 * g) = packf4(o[dt] * vis1());
    }
    __syncthreads();
}

__device__ __forceinline__ void ret_unit(LAS unsigned char* lds, const bf16* QR, const bf16* KR, const bf16* VR, const bf16* GR, const bf16* ST, bf16* RET, int unit, int tid, int lane, int wid) {
    constexpr int PKR = 272, PS = 272, PBV = 544;
    LAS unsigned char* Kimg = lds; LAS unsigned char* Ximg = lds + 128 * PKR;
    const int n = unit & 63, bh = unit >> 6, b = bh >> 2, h = bh & 3;
    const float lg2 = log2f(1.f - exp2f(-5.f - (float)h));
    const size_t t0 = (size_t)b * SEQ + n * 128;
    const int c16 = lane & 15, g = lane >> 4, q = c16 >> 2, p = c16 & 3, i = 16 * wid + c16;
#pragma unroll
    for (int it = 0; it < 4; ++it) { const int c = tid + it * NTHR, j = c >> 4, ch = c & 15;
        *(LAS v4u*)(Kimg + j * PKR + ch * 16) = *(const v4u*)(KR + (t0 + j) * 512 + h * 128 + ch * 8); }
#pragma unroll
    for (int it = 0; it < 8; ++it) { const int c = tid + it * NTHR, e = c >> 4, ch = c & 15;
        *(LAS v4u*)(Ximg + e * PS + ch * 16) = *(const v4u*)(ST + ((size_t)unit * 256 + e) * 128 + ch * 8); }
    bf16x8 qf[4];
#pragma unroll
    for (int ks = 0; ks < 4; ++ks) qf[ks] = *(const bf16x8*)(QR + (t0 + i) * 512 + h * 128 + 32 * ks + 8 * g);
    __syncthreads();
    f32x4 s1[8];
#pragma unroll
    for (int jt = 0; jt < 8; ++jt) { s1[jt] = (f32x4){0.f, 0.f, 0.f, 0.f};
        if (jt <= wid) {
#pragma unroll
            for (int ks = 0; ks < 4; ++ks) { const bf16x8 A = *(const LAS bf16x8*)(Kimg + (16 * jt + c16) * PKR + (32 * ks + 8 * g) * 2); s1[jt] = MFMA16(A, qf[ks], s1[jt]); }
#pragma unroll
            for (int rr = 0; rr < 4; ++rr) { const int j = 16 * jt + 4 * g + rr; s1[jt][rr] = (i >= j) ? s1[jt][rr] * __builtin_amdgcn_exp2f((float)(i - j) * lg2) : 0.f; }
        } }
    bf16x8 pf[4];
#pragma unroll
    for (int kp = 0; kp < 4; ++kp) pf[kp] = packf8(s1[2 * kp], s1[2 * kp + 1]);
    f32x4 acc[16];
    const float sc = exp2f((float)(i + 1) * lg2);
#pragma unroll
    for (int et = 0; et < 16; ++et) { acc[et] = (f32x4){0.f, 0.f, 0.f, 0.f};
#pragma unroll
        for (int ks = 0; ks < 4; ++ks) { const bf16x8 A = *(const LAS bf16x8*)(Ximg + (16 * et + c16) * PS + (32 * ks + 8 * g) * 2); acc[et] = MFMA16(A, qf[ks], acc[et]); }
        acc[et] = acc[et] * sc; }
    __syncthreads();
#pragma unroll
    for (int it = 0; it < 8; ++it) { const int c = tid + it * NTHR, j = c >> 5, ch = c & 31;
        *(LAS v4u*)(Ximg + j * PBV + ch * 16) = *(const v4u*)(VR + (t0 + j) * 1024 + h * 256 + ch * 8); }
    __syncthreads();
#pragma unroll
    for (int kp = 0; kp < 4; ++kp) {
        if (2 * kp <= wid) { const LAS unsigned char* va = Ximg + (32 * kp + 4 * g + q) * PBV + p * 8;
#pragma unroll
            for (int et = 0; et < 16; ++et) acc[et] = MFMA16(cat8(trrd(va + et * 32), trrd(va + 16 * PBV + et * 32)), pf[kp], acc[et]); } }
    float sm = 0.f;
#pragma unroll
    for (int et = 0; et < 16; ++et) sm += (acc[et][0] + acc[et][1]) + (acc[et][2] + acc[et][3]);
    sm += __shfl_xor(sm, 16); sm += __shfl_xor(sm, 32);
    const float mean = sm * (1.f / 256.f); float sq = 0.f;
#pragma unroll
    for (int et = 0; et < 16; ++et) { acc[et] = acc[et] - mean; sq += (acc[et][0] * acc[et][0] + acc[et][1] * acc[et][1]) + (acc[et][2] * acc[et][2] + acc[et][3] * acc[et][3]); }
    sq += __shfl_xor(sq, 16); sq += __shfl_xor(sq, 32);
    const float rstd = rsqrtf(sq * (1.f / 256.f) + EPS);
#pragma unroll
    for (int et = 0; et < 16; ++et) { const size_t oi = (t0 + i) * 1024 + h * 256 + 16 * et + 4 * g;
        const f32x4 gt = unpk4(*(const v2u*)(GR + oi)); *(v2u*)(RET + oi + (t0 + i) * 512) = packf4(acc[et] * rstd * gt); }
    __syncthreads();
}

__device__ __forceinline__ float lg2gamma(int h) { return log2f(1.f - exp2f(-5.f - (float)h)); }

__device__ __forceinline__ void kv_load(const bf16* KR, const bf16* VR, int unit, int tid, v4u (&kreg)[4], v4u (&vreg)[8]) {
    const int n = unit & 63, bh = unit >> 6, b = bh >> 2, h = bh & 3; const size_t t0 = (size_t)b * SEQ + n * 128;
#pragma unroll
    for (int it = 0; it < 4; ++it) { const int c = tid + it * NTHR, j = c >> 4, ch = c & 15; kreg[it] = *(const v4u*)(KR + (t0 + j) * 512 + h * 128 + ch * 8); }
#pragma unroll
    for (int it = 0; it < 8; ++it) { const int c = tid + it * NTHR, j = c >> 5, ch = c & 31; vreg[it] = *(const v4u*)(VR + (t0 + j) * 1024 + h * 256 + ch * 8); }
}
__device__ __forceinline__ void kv_phase(LAS unsigned char* lds, const bf16* KR, const bf16* VR, bf16* ST, int first, int stride, int tid_, int lane_, int wid) {
    constexpr int PBK = 288, PBV = 544;
    LAS unsigned char* Kimg = lds; LAS unsigned char* Vimg = lds + 128 * PBK;
    v4u kreg[4], vreg[8];
    if (first < 1024) kv_load(KR, VR, first, tid_, kreg, vreg);
#pragma unroll 1
    for (int unit = first; unit < 1024; unit += stride) {
        const int h = (unit >> 6) & 3; const float lg2 = lg2gamma(h);
        int tid = tid_, lane = lane_; asm volatile("" : "+v"(tid), "+v"(lane));
        const int c16 = lane & 15, g = lane >> 4, q = c16 >> 2, p = c16 & 3;
#pragma unroll
        for (int it = 0; it < 4; ++it) { const int c = tid + it * NTHR, j = c >> 4, ch = c & 15; const v4u w = kreg[it]; const float dec = exp2f((float)(127 - j) * lg2);
            const f32x4 a = unpk4((v2u){w.x, w.y}) * dec, bb = unpk4((v2u){w.z, w.w}) * dec;
            *(LAS bf16x8*)(Kimg + j * PBK + ch * 16) = packf8(a, bb); }
#pragma unroll
        for (int it = 0; it < 8; ++it) { const int c = tid + it * NTHR, j = c >> 5, ch = c & 31; *(LAS v4u*)(Vimg + j * PBV + ch * 16) = vreg[it]; }
        __syncthreads();
        if (unit + stride < 1024) kv_load(KR, VR, unit + stride, tid, kreg, vreg);
        f32x4 acc[8][2];
#pragma unroll
        for (int dt = 0; dt < 8; ++dt) { acc[dt][0] = (f32x4){0.f, 0.f, 0.f, 0.f}; acc[dt][1] = (f32x4){0.f, 0.f, 0.f, 0.f}; }
#pragma unroll
        for (int ks = 0; ks < 4; ++ks) {
            const LAS unsigned char* ka = Kimg + (32 * ks + 4 * g + q) * PBK + p * 8;
            const LAS unsigned char* va = Vimg + (32 * ks + 4 * g + q) * PBV + p * 8 + wid * 64;
            bf16x8 B[2];
#pragma unroll
            for (int et = 0; et < 2; ++et) B[et] = cat8(trrd(va + et * 32), trrd(va + 16 * PBV + et * 32));
#pragma unroll
            for (int dt = 0; dt < 8; ++dt) { const bf16x8 A = cat8(trrd(ka + dt * 32), trrd(ka + 16 * PBK + dt * 32));
                acc[dt][0] = MFMA16(A, B[0], acc[dt][0]); acc[dt][1] = MFMA16(A, B[1], acc[dt][1]); }
        }
#pragma unroll
        for (int dt = 0; dt < 8; ++dt)
#pragma unroll
            for (int et = 0; et < 2; ++et) *(v2u*)(ST + ((size_t)unit * 256 + 32 * wid + 16 * et + c16) * 128 + 16 * dt + 4 * g) = packf4(acc[dt][et] * vis1());
        __syncthreads();
    }
}

__device__ __forceinline__ void swa_load(const bf16* KVS, int unit, int tid, v4u (&kreg)[4], v4u (&vreg)[4]) {
    const int g2 = unit & 1, n = (unit >> 1) & 63, b = unit >> 7; const size_t t0 = (size_t)b * SEQ + n * 128;
#pragma unroll
    for (int it = 0; it < 4; ++it) { const int c = tid + it * NTHR, j = c >> 3, ch = c & 7;
        kreg[it] = (v4u){0u, 0u, 0u, 0u}; vreg[it] = (v4u){0u, 0u, 0u, 0u};
        if (n > 0 || j >= 128) { const bf16* src = KVS + (t0 + j - 128) * 256 + g2 * 64 + ch * 8; kreg[it] = *(const v4u*)src; vreg[it] = *(const v4u*)(src + 128); } }
}
__device__ __forceinline__ void swa_phase(LAS unsigned char* lds, const bf16* QS, const bf16* KVS, const float* sinks, bf16* SWA, int first, int stride, int tid_, int lane_, int wid) {
    constexpr int PK = 144, PV = 160;
    LAS unsigned char* Kimg = lds; LAS unsigned char* Vimg = lds + 256 * PK;
    const int jt0 = 2 * (wid >> 1);
    v4u kreg[4], vreg[4];
    if (first < 512) swa_load(KVS, first, tid_, kreg, vreg);
#pragma unroll 1
    for (int unit = first; unit < 512; unit += stride) {
        const int g2 = unit & 1, n = (unit >> 1) & 63, b = unit >> 7; const size_t t0 = (size_t)b * SEQ + n * 128;
        int tid = tid_, lane = lane_; asm volatile("" : "+v"(tid), "+v"(lane));
        const int c16 = lane & 15, g = lane >> 4, q = c16 >> 2, p = c16 & 3, i = 16 * wid + c16;
#pragma unroll
        for (int it = 0; it < 4; ++it) { const int c = tid + it * NTHR, j = c >> 3, ch = c & 7; *(LAS v4u*)(Kimg + j * PK + ch * 16) = kreg[it]; *(LAS v4u*)(Vimg + j * PV + ch * 16) = vreg[it]; }
        bf16x8 qf[4][2];
#pragma unroll
        for (int r = 0; r < 4; ++r)
#pragma unroll
            for (int ks = 0; ks < 2; ++ks) qf[r][ks] = *(const bf16x8*)(QS + (t0 + i) * 512 + (g2 * 4 + r) * 64 + 32 * ks + 8 * g);
        __syncthreads();
        if (unit + stride < 512) swa_load(KVS, unit + stride, tid, kreg, vreg);
#pragma unroll
        for (int r = 0; r < 4; ++r) {
            const int hq = g2 * 4 + r;
            const float slope = exp2f(-(float)(hq + 1)), sink = sinks[hq];
            f32x4 s[10];
#pragma unroll
            for (int jt = 0; jt < 10; ++jt) { s[jt] = (f32x4){0.f, 0.f, 0.f, 0.f};
#pragma unroll
                for (int ks = 0; ks < 2; ++ks) { const bf16x8 A = *(const LAS bf16x8*)(Kimg + (16 * (jt0 + jt) + c16) * PK + (32 * ks + 8 * g) * 2); s[jt] = MFMA16(A, qf[r][ks], s[jt]); } }
            float mx = sink;
#pragma unroll
            for (int jt = 0; jt < 10; ++jt)
#pragma unroll
                for (int rr = 0; rr < 4; ++rr) { const int j = 16 * (jt0 + jt) + 4 * g + rr, dist = i + 128 - j;
                    const bool valid = dist >= 0 && dist < 128 && (n > 0 || j >= 128);
                    const float v = valid ? s[jt][rr] - slope * (float)dist : -INFINITY; s[jt][rr] = v; mx = fmaxf(mx, v); }
            mx = fmaxf(mx, __shfl_xor(mx, 16)); mx = fmaxf(mx, __shfl_xor(mx, 32));
            float l = 0.f;
#pragma unroll
            for (int jt = 0; jt < 10; ++jt)
#pragma unroll
                for (int rr = 0; rr < 4; ++rr) { const float v = s[jt][rr]; const float pe = (v == -INFINITY) ? 0.f : __expf(v - mx); s[jt][rr] = pe; l += pe; }
            l += __shfl_xor(l, 16); l += __shfl_xor(l, 32); l += __expf(sink - mx);
            const float inv = 1.f / l;
            bf16x8 pf[5];
#pragma unroll
            for (int kp = 0; kp < 5; ++kp) pf[kp] = packf8(s[2 * kp] * inv, s[2 * kp + 1] * inv);
            f32x4 o[4];
#pragma unroll
            for (int dt = 0; dt < 4; ++dt) o[dt] = (f32x4){0.f, 0.f, 0.f, 0.f};
#pragma unroll
            for (int kp = 0; kp < 5; ++kp) { const LAS unsigned char* va = Vimg + (16 * (jt0 + 2 * kp) + 4 * g + q) * PV + p * 8;
#pragma unroll
                for (int dt = 0; dt < 4; ++dt) o[dt] = MFMA16(cat8(trrd(va + dt * 32), trrd(va + 16 * PV + dt * 32)), pf[kp], o[dt]); }
#pragma unroll
            for (int dt = 0; dt < 4; ++dt) *(v2u*)(SWA + (t0 + i) * 1536 + hq * 64 + 16 * dt + 4 * g) = packf4(o[dt] * vis1());
        }
        __syncthreads();
    }
}

__device__ __forceinline__ void ret_load(const bf16* KR, const bf16* ST, int unit, int tid, v4u (&kreg)[4], v4u (&sreg)[8]) {
    const int n = unit & 63, bh = unit >> 6, b = bh >> 2, h = bh & 3; const size_t t0 = (size_t)b * SEQ + n * 128;
#pragma unroll
    for (int it = 0; it < 4; ++it) { const int c = tid + it * NTHR, j = c >> 4, ch = c & 15; kreg[it] = *(const v4u*)(KR + (t0 + j) * 512 + h * 128 + ch * 8); }
#pragma unroll
    for (int it = 0; it < 8; ++it) { const int c = tid + it * NTHR; sreg[it] = *(const v4u*)(ST + (size_t)unit * 32768 + (size_t)c * 8); }
}
__device__ __forceinline__ void ret_phase(LAS unsigned char* lds, const bf16* QR, const bf16* KR, const bf16* VR, const bf16* GR, const bf16* ST, bf16* RET, int first, int stride, int tid_, int lane_, int wid) {
    constexpr int PKR = 272, PS = 272, PBV = 544;
    LAS unsigned char* Kimg = lds; LAS unsigned char* Ximg = lds + 128 * PKR;
    v4u kreg[4], sreg[8];
    if (first < 1024) ret_load(KR, ST, first, tid_, kreg, sreg);
#pragma unroll 1
    for (int unit = first; unit < 1024; unit += stride) {
        const int n = unit & 63, bh = unit >> 6, b = bh >> 2, h = bh & 3;
        const float lg2 = lg2gamma(h);
        const size_t t0 = (size_t)b * SEQ + n * 128;
        int tid = tid_, lane = lane_; asm volatile("" : "+v"(tid), "+v"(lane));
        const int c16 = lane & 15, g = lane >> 4, q = c16 >> 2, p = c16 & 3, i = 16 * wid + c16;
#pragma unroll
        for (int it = 0; it < 4; ++it) { const int c = tid + it * NTHR, j = c >> 4, ch = c & 15; *(LAS v4u*)(Kimg + j * PKR + ch * 16) = kreg[it]; }
#pragma unroll
        for (int it = 0; it < 8; ++it) { const int c = tid + it * NTHR, e = c >> 4, ch = c & 15; *(LAS v4u*)(Ximg + e * PS + ch * 16) = sreg[it]; }
        bf16x8 qf[4];
#pragma unroll
        for (int ks = 0; ks < 4; ++ks) qf[ks] = *(const bf16x8*)(QR + (t0 + i) * 512 + h * 128 + 32 * ks + 8 * g);
        __syncthreads();
        v4u vreg[8];
#pragma unroll
        for (int it = 0; it < 8; ++it) { const int c = tid + it * NTHR, j = c >> 5, ch = c & 31; vreg[it] = *(const v4u*)(VR + (t0 + j) * 1024 + h * 256 + ch * 8); }
        f32x4 s1[8];
#pragma unroll
        for (int jt = 0; jt < 8; ++jt) { s1[jt] = (f32x4){0.f, 0.f, 0.f, 0.f};
            if (jt <= wid) {
#pragma unroll
                for (int ks = 0; ks < 4; ++ks) { const bf16x8 A = *(const LAS bf16x8*)(Kimg + (16 * jt + c16) * PKR + (32 * ks + 8 * g) * 2); s1[jt] = MFMA16(A, qf[ks], s1[jt]); }
#pragma unroll
                for (int rr = 0; rr < 4; ++rr) { const int j = 16 * jt + 4 * g + rr; s1[jt][rr] = (i >= j) ? s1[jt][rr] * __builtin_amdgcn_exp2f((float)(i - j) * lg2) : 0.f; }
            } }
        bf16x8 pf[4];
#pragma unroll
        for (int kp = 0; kp < 4; ++kp) pf[kp] = packf8(s1[2 * kp], s1[2 * kp + 1]);
        f32x4 acc[16];
        const float sc = exp2f((float)(i + 1) * lg2);
#pragma unroll
        for (int et = 0; et < 16; ++et) { acc[et] = (f32x4){0.f, 0.f, 0.f, 0.f};
#pragma unroll
            for (int ks = 0; ks < 4; ++ks) { const bf16x8 A = *(const LAS bf16x8*)(Ximg + (16 * et + c16) * PS + (32 * ks + 8 * g) * 2); acc[et] = MFMA16(A, qf[ks], acc[et]); }
            acc[et] = acc[et] * sc; if (et & 1) __builtin_amdgcn_sched_barrier(0); }
        __syncthreads();
#pragma unroll
        for (int it = 0; it < 8; ++it) { const int c = tid + it * NTHR, j = c >> 5, ch = c & 31; *(LAS v4u*)(Ximg + j * PBV + ch * 16) = vreg[it]; }
        if (unit + stride < 1024) ret_load(KR, ST, unit + stride, tid, kreg, sreg);
        __syncthreads();
#pragma unroll
        for (int kp = 0; kp < 4; ++kp) {
            if (2 * kp <= wid) { const LAS unsigned char* va = Ximg + (32 * kp + 4 * g + q) * PBV + p * 8;
#pragma unroll
                for (int et = 0; et < 16; ++et) { acc[et] = MFMA16(cat8(trrd(va + et * 32), trrd(va + 16 * PBV + et * 32)), pf[kp], acc[et]); if ((et & 3) == 3) __builtin_amdgcn_sched_barrier(0); } } }
        int tidg = tid; asm volatile("" : "+v"(tidg));
        v4u gtv[8];
#pragma unroll
        for (int k = 0; k < 8; ++k) { const int id = tidg + k * NTHR; gtv[k] = *(const v4u*)(GR + (t0 + (id >> 5)) * 1024 + h * 256 + (id & 31) * 8); }
        float sm = 0.f;
#pragma unroll
        for (int et = 0; et < 16; ++et) sm += (acc[et][0] + acc[et][1]) + (acc[et][2] + acc[et][3]);
        sm += __shfl_xor(sm, 16); sm += __shfl_xor(sm, 32);
        const float mean = sm * (1.f / 256.f); float sq = 0.f;
#pragma unroll
        for (int et = 0; et < 16; ++et) { acc[et] = acc[et] - mean; sq += (acc[et][0] * acc[et][0] + acc[et][1] * acc[et][1]) + (acc[et][2] * acc[et][2] + acc[et][3] * acc[et][3]); }
        sq += __shfl_xor(sq, 16); sq += __shfl_xor(sq, 32);
        const float rstd = rsqrtf(sq * (1.f / 256.f) + EPS);
        __syncthreads();
        {
            constexpr int PO = 528;
#pragma unroll
            for (int et = 0; et < 16; ++et) *(LAS v2u*)(Ximg + i * PO + (16 * et + 4 * g) * 2) = packf4(acc[et] * rstd);
            __syncthreads();
            int tid2 = tid; asm volatile("" : "+v"(tid2));
#pragma unroll
            for (int k = 0; k < 8; ++k) { const int id = tid2 + k * NTHR, row = id >> 5, ch = id & 31;
                const v4u o = *(const LAS v4u*)(Ximg + row * PO + ch * 16); const v4u gq = gtv[k];
                const f32x4 y0 = unpk4((v2u){o.x, o.y}) * unpk4((v2u){gq.x, gq.y}), y1 = unpk4((v2u){o.z, o.w}) * unpk4((v2u){gq.z, gq.w});
                const v2u a0 = packf4(y0), a1 = packf4(y1);
                *(v4u*)(RET + (t0 + row) * 1536 + h * 256 + ch * 8) = (v4u){a0.x, a0.y, a1.x, a1.y}; }
        }
        __syncthreads();
    }
}

__device__ __forceinline__ void p2_load(const bf16* KR, const bf16* VR, const bf16* KVS, int it, int tid, v4u (&r)[12]) {
    if (it < 1024) {
        const int unit = it, n = unit & 63, bh = unit >> 6, b = bh >> 2, h = bh & 3; const size_t t0 = (size_t)b * SEQ + n * 128;
#pragma unroll
        for (int k = 0; k < 4; ++k) { const int c = tid + k * NTHR, j = c >> 4, ch = c & 15; r[k] = *(const v4u*)(KR + (t0 + j) * 512 + h * 128 + ch * 8); }
#pragma unroll
        for (int k = 0; k < 8; ++k) { const int c = tid + k * NTHR, j = c >> 5, ch = c & 31; r[4 + k] = *(const v4u*)(VR + (t0 + j) * 1024 + h * 256 + ch * 8); }
    } else {
        const int unit = it - 1024, g2 = unit & 1, n = (unit >> 1) & 63, b = unit >> 7; const size_t t0 = (size_t)b * SEQ + n * 128;
#pragma unroll
        for (int k = 0; k < 4; ++k) { const int c = tid + k * NTHR, j = c >> 3, ch = c & 7;
            r[k] = (v4u){0u, 0u, 0u, 0u}; r[4 + k] = (v4u){0u, 0u, 0u, 0u};
            if (n > 0 || j >= 128) { const bf16* s = KVS + (t0 + j - 128) * 256 + g2 * 64 + ch * 8; r[k] = *(const v4u*)s; r[4 + k] = *(const v4u*)(s + 128); } }
    }
}
__device__ __forceinline__ void p2_phase(LAS unsigned char* lds, const bf16* KR, const bf16* VR, bf16* ST, const bf16* QS, const bf16* KVS, const float* sinks, bf16* SWA, int first, int stride, int tid_, int lane_, int wid) {
    v4u r[12];
    if (first < 1536) p2_load(KR, VR, KVS, first, tid_, r);
#pragma unroll 1
    for (int it = first; it < 1536; it += stride) {
        int tid = tid_, lane = lane_; asm volatile("" : "+v"(tid), "+v"(lane));
        const int c16 = lane & 15, g = lane >> 4, q = c16 >> 2, p = c16 & 3;
        if (it < 1024) {
            constexpr int PBK = 288, PBV = 544;
            LAS unsigned char* Kimg = lds; LAS unsigned char* Vimg = lds + 128 * PBK;
            const int unit = it, h = (unit >> 6) & 3; const float lg2 = lg2gamma(h);
#pragma unroll
            for (int k = 0; k < 4; ++k) { const int c = tid + k * NTHR, j = c >> 4, ch = c & 15; const v4u w = r[k]; const float dec = exp2f((float)(127 - j) * lg2);
                const f32x4 a = unpk4((v2u){w.x, w.y}) * dec, bb = unpk4((v2u){w.z, w.w}) * dec;
                *(LAS bf16x8*)(Kimg + j * PBK + ch * 16) = packf8(a, bb); }
#pragma unroll
            for (int k = 0; k < 8; ++k) { const int c = tid + k * NTHR, j = c >> 5, ch = c & 31; *(LAS v4u*)(Vimg + j * PBV + ch * 16) = r[4 + k]; }
            __syncthreads();
            if (it + stride < 1536) p2_load(KR, VR, KVS, it + stride, tid, r);
            f32x4 acc[8][2];
#pragma unroll
            for (int dt = 0; dt < 8; ++dt) { acc[dt][0] = (f32x4){0.f, 0.f, 0.f, 0.f}; acc[dt][1] = (f32x4){0.f, 0.f, 0.f, 0.f}; }
#pragma unroll
            for (int ks = 0; ks < 4; ++ks) {
                const LAS unsigned char* ka = Kimg + (32 * ks + 4 * g + q) * PBK + p * 8;
                const LAS unsigned char* va = Vimg + (32 * ks + 4 * g + q) * PBV + p * 8 + wid * 64;
                bf16x8 B[2];
#pragma unroll
                for (int et = 0; et < 2; ++et) B[et] = cat8(trrd(va + et * 32), trrd(va + 16 * PBV + et * 32));
#pragma unroll
                for (int dt = 0; dt < 8; ++dt) { const bf16x8 A = cat8(trrd(ka + dt * 32), trrd(ka + 16 * PBK + dt * 32));
                    acc[dt][0] = MFMA16(A, B[0], acc[dt][0]); acc[dt][1] = MFMA16(A, B[1], acc[dt][1]); }
            }
            __syncthreads();
            {
                constexpr int PT = 272;
#pragma unroll
                for (int dt = 0; dt < 8; ++dt)
#pragma unroll
                    for (int et = 0; et < 2; ++et) *(LAS v2u*)(lds + (32 * wid + 16 * et + c16) * PT + (16 * dt + 4 * g) * 2) = packf4(acc[dt][et] * vis1());
                __syncthreads();
#pragma unroll
                for (int k = 0; k < 8; ++k) { const int id = tid + k * NTHR; *(v4u*)(ST + (size_t)unit * 32768 + (size_t)id * 8) = *(const LAS v4u*)(lds + (id >> 4) * PT + (id & 15) * 16); }
            }
            __syncthreads();
        } else {
            constexpr int PK = 144, PV = 160;
            LAS unsigned char* Kimg = lds; LAS unsigned char* Vimg = lds + 256 * PK;
            const int unit = it - 1024, g2 = unit & 1, n = (unit >> 1) & 63, b = unit >> 7; const size_t t0 = (size_t)b * SEQ + n * 128;
            const int jt0 = 2 * (wid >> 1), i = 16 * wid + c16;
#pragma unroll
            for (int k = 0; k < 4; ++k) { const int c = tid + k * NTHR, j = c >> 3, ch = c & 7; *(LAS v4u*)(Kimg + j * PK + ch * 16) = r[k]; *(LAS v4u*)(Vimg + j * PV + ch * 16) = r[4 + k]; }
            bf16x8 qfa[4][2];
#pragma unroll
            for (int rh = 0; rh < 4; ++rh)
#pragma unroll
                for (int ks = 0; ks < 2; ++ks) qfa[rh][ks] = *(const bf16x8*)(QS + (t0 + i) * 512 + (g2 * 4 + rh) * 64 + 32 * ks + 8 * g);
            __syncthreads();
            if (it + stride < 1536) p2_load(KR, VR, KVS, it + stride, tid, r);
#pragma unroll
            for (int rh = 0; rh < 4; ++rh) {
                const int hq = g2 * 4 + rh;
                const float slope = exp2f(-(float)(hq + 1)), sink = sinks[hq];
                bf16x8 qf[2]; qf[0] = qfa[rh][0]; qf[1] = qfa[rh][1];
                f32x4 s[10];
#pragma unroll
                for (int jt = 0; jt < 10; ++jt) { s[jt] = (f32x4){0.f, 0.f, 0.f, 0.f};
#pragma unroll
                    for (int ks = 0; ks < 2; ++ks) { const bf16x8 A = *(const LAS bf16x8*)(Kimg + (16 * (jt0 + jt) + c16) * PK + (32 * ks + 8 * g) * 2); s[jt] = MFMA16(A, qf[ks], s[jt]); } }
                float mx = sink;
#pragma unroll
                for (int jt = 0; jt < 10; ++jt)
#pragma unroll
                    for (int rr = 0; rr < 4; ++rr) { const int j = 16 * (jt0 + jt) + 4 * g + rr, dist = i + 128 - j;
                        const bool valid = dist >= 0 && dist < 128 && (n > 0 || j >= 128);
                        const float v = valid ? s[jt][rr] - slope * (float)dist : -INFINITY; s[jt][rr] = v; mx = fmaxf(mx, v); }
                mx = fmaxf(mx, __shfl_xor(mx, 16)); mx = fmaxf(mx, __shfl_xor(mx, 32));
                float l = 0.f;
#pragma unroll
                for (int jt = 0; jt < 10; ++jt)
#pragma unroll
                    for (int rr = 0; rr < 4; ++rr) { const float v = s[jt][rr]; const float pe = (v == -INFINITY) ? 0.f : __expf(v - mx); s[jt][rr] = pe; l += pe; }
                l += __shfl_xor(l, 16); l += __shfl_xor(l, 32); l += __expf(sink - mx);
                const float inv = 1.f / l;
                bf16x8 pf[5];
#pragma unroll
                for (int kp = 0; kp < 5; ++kp) pf[kp] = packf8(s[2 * kp] * inv, s[2 * kp + 1] * inv);
                f32x4 o[4];
#pragma unroll
                for (int dt = 0; dt < 4; ++dt) o[dt] = (f32x4){0.f, 0.f, 0.f, 0.f};
#pragma unroll
                for (int kp = 0; kp < 5; ++kp) { const LAS unsigned char* va = Vimg + (16 * (jt0 + 2 * kp) + 4 * g + q) * PV + p * 8;
#pragma unroll
                    for (int dt = 0; dt < 4; ++dt) o[dt] = MFMA16(cat8(trrd(va + dt * 32), trrd(va + 16 * PV + dt * 32)), pf[kp], o[dt]); }
#pragma unroll
                for (int dt = 0; dt < 4; ++dt) *(v2u*)(SWA + (t0 + i) * 1536 + hq * 64 + 16 * dt + 4 * g) = packf4(o[dt] * vis1());
                __builtin_amdgcn_sched_barrier(0);
            }
            __syncthreads();
        }
    }
}
struct Args { const float* in[12]; float* out; unsigned char* ws; int ph_lo, ph_hi; };
constexpr int NPH = 9;
#ifndef PROBE_REP
#define PROBE_REP (-1)
#endif

__global__ void __launch_bounds__(NTHR, 2) mega(Args a) {
    extern __shared__ __attribute__((aligned(16))) unsigned char lds_raw[];
    LAS unsigned char* lds = (LAS unsigned char*)lds_raw;
    cg::grid_group grid = cg::this_grid();
    const int tid = threadIdx.x, lane = tid & 63, wid = __builtin_amdgcn_readfirstlane(tid >> 6);
    const int G = gridDim.x, gw = blockIdx.x * NWAVES + wid, NGW = G * NWAVES;
    unsigned char* ws = a.ws;
    const float* x = a.in[0]; const float* g_premix = a.in[1]; const float* sinks = a.in[6];
    const float* g_postmix = a.in[7]; const float* g_premlp = a.in[8]; const float* g_postmlp = a.in[11];
    bf16* Win_t = (bf16*)(ws + OFF_WIN); bf16* Wr_t = (bf16*)(ws + OFF_WR); bf16* Ws_t = (bf16*)(ws + OFF_WS); bf16* Wo_t = (bf16*)(ws + OFF_WO);
    bf16* Wup_t = (bf16*)(ws + OFF_WUP); bf16* Wdn_t = (bf16*)(ws + OFF_WDN);
    bf16* QR = (bf16*)(ws + OFF_QR); bf16* KR = (bf16*)(ws + OFF_KR); bf16* VR = (bf16*)(ws + OFF_VR); bf16* GR = (bf16*)(ws + OFF_GR);
    bf16* QS = (bf16*)(ws + OFF_QS); bf16* KVS = (bf16*)(ws + OFF_KVS); bf16* GTR = (bf16*)(ws + OFF_GTR); bf16* GTS = (bf16*)(ws + OFF_GTS);
    bf16* ST = (bf16*)(ws + OFF_ST); bf16* TB = (bf16*)(ws + OFF_T); bf16* MG = (bf16*)(ws + OFF_MG); float* Z = (float*)(ws + OFF_Z);
    bf16* H2 = (bf16*)(ws + OFF_H2); bf16* U = (bf16*)(ws + OFF_U); float* DD = (float*)(ws + OFF_DD);
    bf16* HB = (bf16*)a.out; bf16* RET = (bf16*)a.out; bf16* SWA = (bf16*)a.out + 1024;
    float* X1 = a.out; bf16* X1B = (bf16*)(ws + OFF_DD);
    unsigned* CNT = (unsigned*)ws; float* SL1 = (float*)(ws + 34 * MiB); float* SL2 = (float*)(ws + 34 * MiB + 512 * 1024); float* SL3 = (float*)(ws + 35 * MiB);
    const int lo = a.ph_lo, hi = a.ph_hi;
    volatile LAS unsigned* bst = (volatile LAS unsigned*)(lds + 131072 + 64);
    if (tid < 2) bst[tid] = 0u;
    __syncthreads();
    const XcdBarrier bar = xcd_barrier_post((unsigned*)ws + 24576, bst);
    if (a.ph_lo < 0) grid.sync();
#define IN(k) (lo <= (k) && (k) < hi)
#define SEAM(k) do { if (IN(k) && IN((k) + 1)) { xcd_barrier(bar); } } while (0)

    if (IN(0)) {
        LAS float* scr = (LAS float*)(lds + wid * 16384);
        constexpr int I0 = 16 * 184, I1 = 16 * 32, I2 = 8 * 32, I3 = 16 * 32, I4 = 16 * 128, I5 = 64 * 32, NIT = I0 + I1 + I2 + I3;
        for (int it = gw; it < NIT; it += NGW) {
            int r = it;
            if (r < I0) { p0_transpose_item(a.in[2], 1024, DIN, Win_t, scr, r, lane); continue; } r -= I0;
            if (r < I1) { p0_transpose_item(a.in[3], 1024, 1024, Wr_t, scr, r, lane, 1536, 0); continue; } r -= I1;
            if (r < I2) { p0_transpose_item(a.in[4], 512, 1024, Wr_t, scr, r, lane, 1536, 1024); continue; } r -= I2;
            p0_transpose_item(a.in[5], 1024, 1024, Wo_t, scr, r, lane);
        }
        for (int m0 = gw; m0 < M; m0 += 2 * NGW) {
            const int m1 = (m0 + NGW < M) ? m0 + NGW : m0;
            const f32x4* xr0 = (const f32x4*)(x + (size_t)m0 * D) + lane; const f32x4* xr1 = (const f32x4*)(x + (size_t)m1 * D) + lane; f32x4 v0[4], v1[4]; float s0 = 0.f, s1 = 0.f;
#pragma unroll
            for (int j = 0; j < 4; ++j) { v0[j] = xr0[64 * j]; v1[j] = xr1[64 * j]; }
#pragma unroll
            for (int j = 0; j < 4; ++j) { s0 += (v0[j].x * v0[j].x + v0[j].y * v0[j].y) + (v0[j].z * v0[j].z + v0[j].w * v0[j].w); s1 += (v1[j].x * v1[j].x + v1[j].y * v1[j].y) + (v1[j].z * v1[j].z + v1[j].w * v1[j].w); }
            const float rs0 = rsqrtf(wave_sum(s0) * (1.f / D) + EPS), rs1 = rsqrtf(wave_sum(s1) * (1.f / D) + EPS);
            unsigned long long* o80 = (unsigned long long*)(HB + (size_t)m0 * D) + lane; unsigned long long* o81 = (unsigned long long*)(HB + (size_t)m1 * D) + lane;
#pragma unroll
            for (int j = 0; j < 4; ++j) { const f32x4 g = ((const f32x4*)g_premix)[lane + 64 * j]; const f32x4 a0 = v0[j] * rs0 * g, a1 = v1[j] * rs1 * g;
                o80[64 * j] = (unsigned long long)pk2(a0.x, a0.y) | ((unsigned long long)pk2(a0.z, a0.w) << 32);
                o81[64 * j] = (unsigned long long)pk2(a1.x, a1.y) | ((unsigned long long)pk2(a1.z, a1.w) << 32); }
        }
    }
    SEAM(0);
    if (IN(1)) {
        pg8::Gemm g{HB, Win_t, M, DIN, 1024}; pg8::StaticOrder S; S.init(M, DIN, G, (int)blockIdx.x);
        pg8::EpiB<0> E{ws, nullptr, 0, nullptr, nullptr};
        pg8::gemm_phase<pg8::EpiB<0>, pg8::StaticOrder, true, true>(lds, g, S, E);
        {
            constexpr int I4 = 16 * 128, I5 = 64 * 32, NU = (M / 256) * (DIN / 256);
            const int nfull = NU / G, rem = NU - nfull * G;
            const int nidle = G - rem;
            if (rem > 0 && (int)blockIdx.x >= rem) {
                __syncthreads();
                LAS float* scr = (LAS float*)(lds + wid * 16384);
                for (int it = ((int)blockIdx.x - rem) * NWAVES + wid; it < I4 + I5; it += nidle * NWAVES) {
                    if (it < I4) p0_transpose_item(a.in[9], 1024, FF, Wup_t, scr, it, lane, 0, 0, g_premlp);
                    else p0_transpose_item(a.in[10], FF, 1024, Wdn_t, scr, it - I4, lane);
                }
            } else if (rem == 0) {
                __syncthreads();
                LAS float* scr = (LAS float*)(lds + wid * 16384);
                for (int it = gw; it < I4 + I5; it += NGW) {
                    if (it < I4) p0_transpose_item(a.in[9], 1024, FF, Wup_t, scr, it, lane, 0, 0, g_premlp);
                    else p0_transpose_item(a.in[10], FF, 1024, Wdn_t, scr, it - I4, lane);
                }
            }
        }
    }
    SEAM(1);
    if (IN(2)) {
        p2_phase(lds, KR, VR, ST, QS, KVS, sinks, SWA, (int)blockIdx.x, G, tid, lane, wid);
    }
    SEAM(2);
    if (IN(3)) {
        for (int idx = blockIdx.x * NTHR + tid; idx < 16 * 256 * 32; idx += G * NTHR) {
            const int d4 = idx & 31, e = (idx >> 5) & 255, bh = idx >> 13, h = bh & 3;
            const float cd = exp2f(128.f * log2f(1.f - exp2f(-5.f - (float)h)));
            bf16* p = ST + ((size_t)(bh * 64) * 256 + e) * 128 + d4 * 4;
            f32x4 s = (f32x4){0.f, 0.f, 0.f, 0.f};
#pragma unroll 1
            for (int n0 = 0; n0 < 64; n0 += 16) {
                v2u w[16];
#pragma unroll
                for (int u = 0; u < 16; ++u) w[u] = *(const v2u*)(p + (size_t)(n0 + u) * 32768);
#pragma unroll
                for (int u = 0; u < 16; ++u) { *(v2u*)(p + (size_t)(n0 + u) * 32768) = packf4(s); s = s * cd + unpk4(w[u]); }
            }
        }
    }
    SEAM(3);
    if (IN(4)) {
#if USE_NEW_RET
        ret_phase(lds, QR, KR, VR, GR, ST, RET, (int)blockIdx.x, G, tid, lane, wid);
#else
        for (int unit = blockIdx.x; unit < 1024; unit += G) ret_unit(lds, QR, KR, VR, GR, ST, RET, unit, tid, lane, wid);
#endif
    }
    SEAM(4);
    if (IN(5)) {
        pg8::Gemm g{RET, Wr_t, M, 1024, 1536}; pg8::StaticOrder S; S.init(M, 1024, G, (int)blockIdx.x);
        pg8::EpiMerged E{MG, GTR, GTS};
        pg8::gemm_phase<pg8::EpiMerged, pg8::StaticOrder, true, true>(lds, g, S, E);
    }
    SEAM(5);
    if (IN(6)) {
#pragma unroll 1
        for (int pass = 0; pass < (512 + G - 1) / G; ++pass) {
            pg8::Gemm g{MG, Wo_t, M, 1024, 1024}; pg8::OneUnit S; S.base.init(M, 1024, G, (int)blockIdx.x); S.pass = pass;
            pg8::RowSq st1{SL1, CNT, EPS}, st2{SL2, CNT + 8192, EPS};
            pg8::EpiRmsResRms E{x, X1B, g_postmix, st1, st2};
            pg8::gemm_phase<pg8::EpiRmsResRms, pg8::OneUnit, false, true>(lds, g, S, E);
            __syncthreads();
        }
    }
    SEAM(6);
    if (IN(7)) {
        pg8::Gemm g{X1B, Wup_t, M, FF, 1024}; pg8::StaticOrder S; S.init(M, FF, G, (int)blockIdx.x);
        pg8::EpiUp E{U, SL2};
        pg8::gemm_phase<pg8::EpiUp, pg8::StaticOrder, true, true>(lds, g, S, E);
    }
    SEAM(7);
    if (IN(8)) {
#pragma unroll 1
        for (int pass = 0; pass < (512 + G - 1) / G; ++pass) {
            pg8::Gemm g{U, Wdn_t, M, 1024, FF}; pg8::OneUnit S; S.base.init(M, 1024, G, (int)blockIdx.x); S.pass = pass;
            pg8::RowSq st{SL3, CNT + 16384, EPS};
            pg8::EpiRmsRes E{X1B, X1, g_postmlp, st};
            pg8::gemm_phase<pg8::EpiRmsRes, pg8::OneUnit, false, true>(lds, g, S, E);
            __syncthreads();
        }
    }
#undef IN
#undef SEAM
}

extern "C" void kernel_launch(void* const* d_in, const int* in_sizes, int n_in, void* d_out, int out_size, void* d_ws, size_t ws_size, hipStream_t stream) {
    static int grid = 0;
    if (grid == 0) {
        if (n_in != 12 || in_sizes[0] != M * D || out_size != M * D || ws_size < WS_NEED) { fprintf(stderr, "kernel_launch: unexpected shapes (n_in %d, ws %zu)\n", n_in, ws_size); grid = -1; return; }
        int dev = 0, cus = 0, per_cu = 0;
        hipGetDevice(&dev); hipDeviceGetAttribute(&cus, hipDeviceAttributeMultiprocessorCount, dev);
        hipFuncSetAttribute((const void*)mega, hipFuncAttributeMaxDynamicSharedMemorySize, LDS_BYTES);
        hipOccupancyMaxActiveBlocksPerMultiprocessor(&per_cu, (const void*)mega, NTHR, LDS_BYTES);
        if (per_cu < 1) { fprintf(stderr, "kernel_launch: occupancy query says %d blocks/CU\n", per_cu); per_cu = 1; }
        (void)hipGetLastError();
        grid = cus * 1;
    }
    if (grid < 0) return;
    if (hipMemsetAsync(d_ws, 0, 128 * 1024, stream) != hipSuccess) { fprintf(stderr, "kernel_launch: memset failed\n"); return; }
    Args a{};
    for (int i = 0; i < 12; ++i) a.in[i] = (const float*)d_in[i];
    a.out = (float*)d_out; a.ws = (unsigned char*)d_ws; a.ph_lo = 0; a.ph_hi = NPH;
    void* args[] = {&a};
    hipError_t e = hipLaunchCooperativeKernel((const void*)mega, dim3(grid), dim3(NTHR), args, LDS_BYTES, stream);
    if (e != hipSuccess) fprintf(stderr, "cooperative launch failed: %s (grid %d)\n", hipGetErrorString(e), grid);
}
```
